# Optimizing an MI355X kernel written in HIP

```python
import jax, jax.numpy as jnp
from jax import lax
import numpy as np

D_MODEL = 2048
BATCH = 1
SEQ = 16384
DEPTH = 1

M_HEADS = 4
M_HEAD_DIM = 256
M_WIDTH = M_HEADS * M_HEAD_DIM
M_CHUNK = 128
CONV_WIDTH = 4
A_HEADS = 8
A_HEAD_DIM = 128
A_WIDTH = A_HEADS * A_HEAD_DIM
MOBA_BLOCK = 256
MOBA_TOPK = 3
Q_BLOCK = 128
ROPE_THETA = 10000.0
D_FF = 4 * D_MODEL
NORM_EPS = 1e-6

SPLITS = (M_WIDTH, M_WIDTH, M_WIDTH, M_WIDTH, M_HEADS, M_HEADS,
          A_WIDTH, A_WIDTH, A_WIDTH, D_MODEL, D_MODEL)
IN_COLS = 4 * M_WIDTH + 2 * M_HEADS + 3 * A_WIDTH + 2 * D_MODEL

kernel_name = 'mlstm_moba_gated_hybrid_block'


def rmsnorm(x, w):
    xf = x.astype(jnp.float32)
    y = xf * lax.rsqrt(jnp.mean(xf * xf, axis=-1, keepdims=True) + NORM_EPS)
    return (y * w.astype(jnp.float32)).astype(x.dtype)


def split_cols(u):
    outs, start = [], 0
    for width in SPLITS:
        outs.append(u[..., start:start + width])
        start += width
    return outs


def to_heads(u, n_heads):
    B, S, C = u.shape
    return u.reshape(B, S, n_heads, C // n_heads).transpose(0, 2, 1, 3)


def causal_depthwise_conv(u, w, b):
    S = u.shape[1]
    up = jnp.pad(u, ((0, 0), (CONV_WIDTH - 1, 0), (0, 0)))
    out = b
    for j in range(CONV_WIDTH):
        out = out + w[j] * up[:, j:j + S]
    return out


def apply_rope(x, positions):
    D = x.shape[-1]
    inv_freq = 1.0 / (ROPE_THETA ** (jnp.arange(0, D, 2, dtype=jnp.float32) / D))
    ang = positions.astype(jnp.float32)[..., None] * inv_freq
    ang = jnp.concatenate([ang, ang], axis=-1)[:, None]
    xf = x.astype(jnp.float32)
    x1, x2 = xf[..., :D // 2], xf[..., D // 2:]
    rot = jnp.concatenate([-x2, x1], axis=-1)
    return (xf * jnp.cos(ang) + rot * jnp.sin(ang)).astype(x.dtype)


def mlstm_chunkwise(q, k, v, i_pre, f_pre):
    B, H, S, D = q.shape
    L = M_CHUNK
    NC = S // L
    f32 = jnp.float32
    q = q.astype(f32).reshape(B, H, NC, L, D)
    k = (k.astype(f32) * (D ** -0.5)).reshape(B, H, NC, L, D)
    v = v.astype(f32).reshape(B, H, NC, L, D)
    log_f = jax.nn.log_sigmoid(f_pre.astype(f32)).reshape(B, H, NC, L)
    log_i = i_pre.astype(f32).reshape(B, H, NC, L)
    b = jnp.cumsum(log_f, axis=-1)
    F = b[..., -1]

    w = F[..., None] - b + log_i
    m_loc = jnp.max(w, axis=-1)
    e = jnp.exp(w - m_loc[..., None])
    C_loc = jnp.einsum('bhclv,bhclk->bhcvk', v * e[..., None], k)
    n_loc = jnp.einsum('bhcl,bhclk->bhck', e, k)

    def step(carry, xs):
        C, n, m = carry
        Fc, Cl, nl, ml = xs
        m_new = jnp.maximum(Fc + m, ml)
        a = jnp.exp(Fc + m - m_new)
        g = jnp.exp(ml - m_new)
        C_new = a[..., None, None] * C + g[..., None, None] * Cl
        n_new = a[..., None] * n + g[..., None] * nl
        return (C_new, n_new, m_new), (C, n, m)

    init = (jnp.zeros((B, H, D, D), f32), jnp.zeros((B, H, D), f32), jnp.zeros((B, H), f32))
    xs = (jnp.moveaxis(F, 2, 0), jnp.moveaxis(C_loc, 2, 0),
          jnp.moveaxis(n_loc, 2, 0), jnp.moveaxis(m_loc, 2, 0))
    _, (C_prev, n_prev, m_prev) = lax.scan(step, init, xs)
    C_prev = jnp.moveaxis(C_prev, 0, 2)
    n_prev = jnp.moveaxis(n_prev, 0, 2)
    m_prev = jnp.moveaxis(m_prev, 0, 2)

    a_log = b + m_prev[..., None]
    d_log = b[..., :, None] - b[..., None, :] + log_i[..., None, :]
    causal = jnp.tril(jnp.ones((L, L), dtype=bool))
    d_log = jnp.where(causal, d_log, -jnp.inf)
    m_t = jnp.maximum(a_log, jnp.max(d_log, axis=-1))
    s_ts = jnp.einsum('bhctd,bhcsd->bhcts', q, k) * jnp.exp(d_log - m_t[..., None])
    inter = jnp.exp(a_log - m_t)
    num = (inter[..., None] * jnp.einsum('bhcvk,bhctk->bhctv', C_prev, q)
           + jnp.einsum('bhcts,bhcsv->bhctv', s_ts, v))
    den = inter * jnp.einsum('bhck,bhctk->bhct', n_prev, q) + jnp.sum(s_ts, axis=-1)
    h = num / jnp.maximum(jnp.abs(den), jnp.exp(-m_t))[..., None]
    return h.reshape(B, H, S, D)


def moba_attention(q, k, v):
    B, H, S, D = q.shape
    BS = MOBA_BLOCK
    NB = -(-S // BS)
    K_SEL = min(MOBA_TOPK, NB)
    pad = NB * BS - S
    kp = jnp.pad(k, ((0, 0), (0, 0), (0, pad), (0, 0))).reshape(B, H, NB, BS, D)
    vp = jnp.pad(v, ((0, 0), (0, 0), (0, pad), (0, 0))).reshape(B, H, NB, BS, D)
    k_mean = jnp.mean(kp.astype(jnp.float32), axis=3)
    scale = D ** -0.5
    NQB = S // Q_BLOCK
    blk_ids = jnp.arange(NB)
    b_idx = jnp.arange(B)[:, None, None, None]
    h_idx = jnp.arange(H)[None, :, None, None]
    n_sel = K_SEL * BS

    def one_block(qb):
        start = qb * Q_BLOCK
        qf = lax.dynamic_slice_in_dim(q, start, Q_BLOCK, axis=2).astype(jnp.float32)
        own = start // BS
        gate = jnp.einsum('bhqd,bhnd->bhqn', qf, k_mean)
        gate = jnp.where(blk_ids < own, gate, -jnp.inf)
        _, sel = lax.top_k(gate, K_SEL)
        valid = jnp.arange(K_SEL) < own
        k_sel = kp[b_idx, h_idx, sel].astype(jnp.float32)
        v_sel = vp[b_idx, h_idx, sel].astype(jnp.float32)
        s_sel = jnp.einsum('bhqd,bhqnkd->bhqnk', qf, k_sel) * scale
        s_sel = jnp.where(valid[:, None], s_sel, -jnp.inf).reshape(B, H, Q_BLOCK, n_sel)
        k_own = lax.dynamic_index_in_dim(kp, own, axis=2, keepdims=False).astype(jnp.float32)
        v_own = lax.dynamic_index_in_dim(vp, own, axis=2, keepdims=False).astype(jnp.float32)
        s_own = jnp.einsum('bhqd,bhkd->bhqk', qf, k_own) * scale
        q_pos = start + jnp.arange(Q_BLOCK)
        k_pos = own * BS + jnp.arange(BS)
        s_own = jnp.where(k_pos[None, :] <= q_pos[:, None], s_own, -jnp.inf)
        p = jax.nn.softmax(jnp.concatenate([s_sel, s_own], axis=-1), axis=-1)
        o = (jnp.einsum('bhqm,bhqmd->bhqd', p[..., :n_sel],
                        v_sel.reshape(B, H, Q_BLOCK, n_sel, D))
             + jnp.einsum('bhqk,bhkd->bhqd', p[..., n_sel:], v_own))
        return o.astype(q.dtype)

    out = lax.map(one_block, jnp.arange(NQB))
    return jnp.moveaxis(out, 0, 2).reshape(B, H, S, D)


def setup_inputs(seed: int = 0) -> dict:
    key = jax.random.key(seed)
    ks = jax.random.split(key, 16)
    f32 = jnp.float32

    def gain(k, n):
        return 1.0 + 0.05 * jax.random.normal(k, (DEPTH, n), f32)

    def dense(k, fan_in, fan_out):
        return jax.random.normal(k, (DEPTH, fan_in, fan_out), f32) * (fan_in ** -0.5)

    x = jax.random.normal(ks[0], (BATCH, SEQ, D_MODEL), f32)
    positions = jnp.broadcast_to(jnp.arange(SEQ, dtype=jnp.int32), (BATCH, SEQ))
    f_bias = (jnp.linspace(3.0, 6.0, M_HEADS, dtype=f32)[None, :]
              + 0.1 * jax.random.normal(ks[6], (DEPTH, M_HEADS), f32))
    return {
        'x': x,
        'positions': positions,
        'norm_mix_pre': gain(ks[1], D_MODEL),
        'w_in': dense(ks[2], D_MODEL, IN_COLS),
        'conv_w': jax.random.normal(ks[3], (DEPTH, CONV_WIDTH, 2 * M_WIDTH), f32) * (CONV_WIDTH ** -0.5),
        'conv_b': 0.01 * jax.random.normal(ks[4], (DEPTH, 2 * M_WIDTH), f32),
        'i_bias': 0.1 * jax.random.normal(ks[5], (DEPTH, M_HEADS), f32),
        'f_bias': f_bias,
        'mlstm_norm': gain(ks[7], M_WIDTH),
        'w_branch_m': dense(ks[8], M_WIDTH, D_MODEL),
        'w_branch_a': dense(ks[9], A_WIDTH, D_MODEL),
        'w_out': dense(ks[10], D_MODEL, D_MODEL),
        'norm_mix_post': gain(ks[11], D_MODEL),
        'norm_ffn_pre': gain(ks[12], D_MODEL),
        'w_up': dense(ks[13], D_MODEL, D_FF),
        'w_down': dense(ks[14], D_FF, D_MODEL),
        'norm_ffn_post': gain(ks[15], D_MODEL),
    }


def reference(x, positions, norm_mix_pre, w_in, conv_w, conv_b, i_bias, f_bias, mlstm_norm,
              w_branch_m, w_branch_a, w_out, norm_mix_post, norm_ffn_pre, w_up, w_down,
              norm_ffn_post):
    dt = x.dtype
    B, S, _ = x.shape
    for l in range(DEPTH):
        xn = rmsnorm(x, norm_mix_pre[l])
        proj = jnp.einsum('bsd,dc->bsc', xn, w_in[l])
        mq, mk, mv, mo, mi, mf, aq, ak, av, g_m, g_a = split_cols(proj)

        qk = jax.nn.silu(causal_depthwise_conv(jnp.concatenate([mq, mk], axis=-1),
                                               conv_w[l], conv_b[l]))
        mq_h = to_heads(qk[..., :M_WIDTH], M_HEADS)
        mk_h = to_heads(qk[..., M_WIDTH:], M_HEADS)
        mv_h = to_heads(mv, M_HEADS)
        i_pre = jnp.transpose(mi + i_bias[l], (0, 2, 1))
        f_pre = jnp.transpose(mf + f_bias[l], (0, 2, 1))
        h = mlstm_chunkwise(mq_h, mk_h, mv_h, i_pre, f_pre)
        h = h * lax.rsqrt(jnp.mean(h * h, axis=-1, keepdims=True) + NORM_EPS)
        h = h.transpose(0, 2, 1, 3).reshape(B, S, M_WIDTH) * mlstm_norm[l].astype(jnp.float32)
        h_m = (h * jax.nn.sigmoid(mo.astype(jnp.float32))).astype(dt)

        aq_h = apply_rope(to_heads(aq, A_HEADS), positions)
        ak_h = apply_rope(to_heads(ak, A_HEADS), positions)
        av_h = to_heads(av, A_HEADS)
        o_a = moba_attention(aq_h, ak_h, av_h)
        h_a = o_a.transpose(0, 2, 1, 3).reshape(B, S, A_WIDTH)

        y_m = jnp.einsum('bsc,cd->bsd', h_m, w_branch_m[l])
        y_a = jnp.einsum('bsc,cd->bsd', h_a, w_branch_a[l])
        merged = jax.nn.sigmoid(g_m) * y_m + jax.nn.sigmoid(g_a) * y_a
        mix_out = jnp.einsum('bsd,de->bse', merged, w_out[l])
        x = x + rmsnorm(mix_out, norm_mix_post[l])

        hn = rmsnorm(x, norm_ffn_pre[l])
        u = jnp.square(jax.nn.relu(jnp.einsum('bsd,df->bsf', hn, w_up[l])))
        y = jnp.einsum('bsf,fd->bsd', u, w_down[l])
        x = x + rmsnorm(y, norm_ffn_post[l])
    return x
```

```cpp
#include <hip/hip_runtime.h>
#include <hip/hip_cooperative_groups.h>
#include <cstdio>
namespace cg = cooperative_groups;
namespace pg8 {
#define PG8_LAS __attribute__((address_space(3)))
typedef unsigned short bf16_t;
typedef short bf16x8 __attribute__((ext_vector_type(8)));
typedef float f32x4 __attribute__((ext_vector_type(4)));
typedef unsigned u32x4 __attribute__((ext_vector_type(4)));
constexpr int BM = 256, BK = 64, HALF = 128, HTB = HALF * BK * 2  , STAGE_BYTES = 8 * HTB, NXCD = 8, WGM = 8;

__host__ __device__ __forceinline__ int lds_byte(int r, int c) { const int st = (r >> 4) * 2 + (c >> 5), rr = r & 15, cc = c & 31, ob = rr * 64 + cc * 2; return st * 1024 + (ob ^ (((ob >> 9) & 1) << 5)); }
__host__ __device__ __forceinline__ void stage_rc(int b, int& R, int& C) { const int st = b / 1024, sb = b % 1024, swz = sb ^ (((sb >> 9) & 1) << 5); R = (st >> 1) * 16 + swz / 64; C = (st & 1) * 32 + (swz % 64) / 2; }
__host__ __device__ __forceinline__ int perm32(int rho) { const int n = rho >> 4, i = rho & 15; return 8 * (i >> 2) + 4 * n + (i & 3); }

struct Unit { int pm, pn; };
struct Gemm { const bf16_t* A; const bf16_t* Bt; int M, N, K; };

struct StaticOrder {
    int nM, nN, nwg, G, c;
    __host__ __device__ void init(int M, int N, int G_, int c_) { nM = M / BM; nN = N / BM; nwg = nM * nN; G = G_; c = c_; }
    __host__ __device__ bool next(int i, Unit& u) const {
        const long L = (long)i * G + c; if (L >= nwg) return false;
        int wgid = (int)L; { const int q = nwg / NXCD, r = nwg % NXCD, xcd = wgid % NXCD, off = wgid / NXCD; wgid = (xcd < r ? xcd * (q + 1) : r * (q + 1) + (xcd - r) * q) + off; }
        const int nig = WGM * nN, gid = wgid / nig, fm = gid * WGM, gsz = (nM - fm) < WGM ? (nM - fm) : WGM;
        u.pm = fm + ((wgid % nig) % gsz); u.pn = (wgid % nig) / gsz; return true;
    }
    __device__ __forceinline__ void a_ready(const Unit&) const {}
    __device__ __forceinline__ void done(const Unit&) const {}
};
__device__ __forceinline__ unsigned cvt_pk_bf16(float lo, float hi) { unsigned r; asm volatile("v_cvt_pk_bf16_f32 %0, %1, %2" : "=v"(r) : "v"(lo), "v"(hi)); return r; }
typedef float f32x2 __attribute__((ext_vector_type(2)));
__device__ __forceinline__ float sigm(float x) { return 1.0f / (1.0f + __expf(-x)); }
__device__ __forceinline__ float bflo(unsigned w) { return __uint_as_float(w << 16); }
__device__ __forceinline__ float bfhi(unsigned w) { return __uint_as_float(w & 0xffff0000u); }
template <int MODE> struct EpiB {
    static constexpr bool PERM = true, AFTER_DRAIN = false;
    bf16_t* O; int ldc; const bf16_t* aux;
    __device__ __forceinline__ void operator()(const f32x4 (&acc)[2][2][4][2], const Unit& u, int wr, int wc, int fr, int fq) const {
        const int row0 = u.pm * BM + wr * 64 + fr, col0 = u.pn * BM + wc * 32 + 8 * fq;
#pragma unroll
        for (int ai = 0; ai < 2; ++ai)
#pragma unroll
            for (int m = 0; m < 4; ++m) { const size_t off = (size_t)(row0 + ai * HALF + m * 16) * ldc + col0;
#pragma unroll
                for (int bj = 0; bj < 2; ++bj) { f32x4 v0 = acc[ai][bj][m][0], v1 = acc[ai][bj][m][1]; const size_t o = off + bj * HALF;
                    if (MODE == 1 || MODE == 2) { const u32x4 g = *(const u32x4*)(aux + o);
                        v0[0] *= sigm(bflo(g.x)); v0[1] *= sigm(bfhi(g.x)); v0[2] *= sigm(bflo(g.y)); v0[3] *= sigm(bfhi(g.y));
                        v1[0] *= sigm(bflo(g.z)); v1[1] *= sigm(bfhi(g.z)); v1[2] *= sigm(bflo(g.w)); v1[3] *= sigm(bfhi(g.w)); }
                    if (MODE == 2) { const u32x4 p = *(const u32x4*)(O + o);
                        v0[0] += bflo(p.x); v0[1] += bfhi(p.x); v0[2] += bflo(p.y); v0[3] += bfhi(p.y);
                        v1[0] += bflo(p.z); v1[1] += bfhi(p.z); v1[2] += bflo(p.w); v1[3] += bfhi(p.w); }
                    if (MODE == 3) {
#pragma unroll
                        for (int j = 0; j < 4; ++j) { const float a = fmaxf(v0[j], 0.f), b = fmaxf(v1[j], 0.f); v0[j] = a * a; v1[j] = b * b; } }
                    u32x4 w; w.x = cvt_pk_bf16(v0[0], v0[1]); w.y = cvt_pk_bf16(v0[2], v0[3]); w.z = cvt_pk_bf16(v1[0], v1[1]); w.w = cvt_pk_bf16(v1[2], v1[3]);
                    *(u32x4*)(O + o) = w; } }
    }
};
struct EpiSplit {
    static constexpr bool PERM = true, AFTER_DRAIN = false;
    bf16_t* MQK; bf16_t* MV; bf16_t* GM; bf16_t* GA;
    __device__ __forceinline__ void operator()(const f32x4 (&acc)[2][2][4][2], const Unit& u, int wr, int wc, int fr, int fq) const {
        bf16_t* base; int ldc, colt; const int pn = u.pn;
        if (pn < 8) { base = MQK; ldc = 2048; colt = pn * 256; }
        else if (pn < 28) { const int t = (pn - 8) >> 2; base = MV + (size_t)t * ((size_t)16384 * 1024); ldc = 1024; colt = ((pn - 8) & 3) * 256; }
        else if (pn < 36) { base = GM; ldc = 2048; colt = (pn - 28) * 256; }
        else { base = GA; ldc = 2048; colt = (pn - 36) * 256; }
        const int row0 = u.pm * BM + wr * 64 + fr, col0 = colt + wc * 32 + 8 * fq;
#pragma unroll
        for (int ai = 0; ai < 2; ++ai)
#pragma unroll
            for (int m = 0; m < 4; ++m) { bf16_t* rowp = base + (size_t)(row0 + ai * HALF + m * 16) * ldc + col0;
#pragma unroll
                for (int bj = 0; bj < 2; ++bj) { const f32x4 v0 = acc[ai][bj][m][0], v1 = acc[ai][bj][m][1];
                    u32x4 w; w.x = cvt_pk_bf16(v0[0], v0[1]); w.y = cvt_pk_bf16(v0[2], v0[3]); w.z = cvt_pk_bf16(v1[0], v1[1]); w.w = cvt_pk_bf16(v1[2], v1[3]);
                    *(u32x4*)(rowp + bj * HALF) = w; } }
    }
};

template <class Epi, class Sched, bool STAMP = false>
__device__ __forceinline__ void gemm_phase(PG8_LAS unsigned char* lds, const Gemm g, const Sched& S, const Epi& E, unsigned long long* stamps) {
    const int tid = threadIdx.x, wid = __builtin_amdgcn_readfirstlane(tid >> 6), lane = tid & 63, wr = wid >> 2, wc = wid & 3, fr = lane & 15, fq = lane >> 4;
    const int K = g.K, nt = K / BK;
    int ts_lo = 0, ts_hi = 0, nts = 0; const unsigned long long rt_entry = STAMP ? (unsigned long long)wall_clock64() : 0ull;
#define PG8_STAMP() do { if (STAMP && wid == 0 && nts < 64) { const unsigned long long _c = (unsigned long long)clock64(); \
        ts_lo = (lane == nts) ? (int)(unsigned)_c : ts_lo; ts_hi = (lane == nts) ? (int)(unsigned)(_c >> 32) : ts_hi; ++nts; } } while (0)
    PG8_STAMP();
    unsigned voffA[2], voffB[2];
#pragma unroll
    for (int i = 0; i < 2; ++i) { int R, C; stage_rc(tid * 16 + i * 8192, R, C); const int Rb = Epi::PERM ? ((R & ~31) + perm32(R & 31)) : R;
        voffA[i] = (unsigned)(R * K + C) * 2u; voffB[i] = (unsigned)(Rb * K + C) * 2u; }
    const size_t kstep = (size_t)(BK * 2);
    const size_t hstep = (size_t)HALF * K * 2;
    const size_t tstep = 2 * hstep;
    const unsigned ldsw = (unsigned)wid * 1024u;
    const int aoff = lds_byte(wr * 64 + fr, fq * 8), boff = lds_byte(wc * 32 + fr, fq * 8);
#define PG8_SA(b, h) (((b) * 2 + (h)) * HTB)
#define PG8_SB(b, h) ((4 + (b) * 2 + (h)) * HTB)
#define PG8_STAGE(bufoff, gbase, voff) do { _Pragma("unroll") for (int _i = 0; _i < 2; ++_i) \
        __builtin_amdgcn_global_load_lds((const unsigned*)((const char*)(gbase) + (voff)[_i]), (PG8_LAS unsigned*)(lds + (bufoff) + ldsw + _i * 8192), 16, 0, 0); } while (0)
#define PG8_LDA(dst, b, h) do { _Pragma("unroll") for (int m = 0; m < 4; ++m) _Pragma("unroll") for (int k = 0; k < 2; ++k) dst[m][k] = *(const PG8_LAS bf16x8*)(lds + PG8_SA(b, h) + aoff + m * 2048 + k * 1024); } while (0)
#define PG8_LDB(dst, b, h) do { _Pragma("unroll") for (int n = 0; n < 2; ++n) _Pragma("unroll") for (int k = 0; k < 2; ++k) dst[n][k] = *(const PG8_LAS bf16x8*)(lds + PG8_SB(b, h) + boff + n * 2048 + k * 1024); } while (0)
#define PG8_MMA(ai, bj, At, Bt) do { __builtin_amdgcn_s_setprio(1); _Pragma("unroll") for (int m = 0; m < 4; ++m) _Pragma("unroll") for (int n = 0; n < 2; ++n) _Pragma("unroll") for (int k = 0; k < 2; ++k) \
        acc[ai][bj][m][n] = __builtin_amdgcn_mfma_f32_16x16x32_bf16(Bt[n][k], At[m][k], acc[ai][bj][m][n], 0, 0, 0); __builtin_amdgcn_s_setprio(0); } while (0)
#define PG8_WAIT_V(n) asm volatile("s_waitcnt vmcnt(" #n ")" ::: "memory")
#define PG8_WAIT_L(n) asm volatile("s_waitcnt lgkmcnt(" #n ")" ::: "memory")
#define PG8_BAR __builtin_amdgcn_s_barrier()
#define PG8_SCHED __builtin_amdgcn_sched_barrier(0)
    Unit cur, nxt; int ui = 0;
    if (!S.next(0, cur)) return;
    f32x4 acc[2][2][4][2];
#pragma unroll
    for (int a = 0; a < 2; ++a)
#pragma unroll
        for (int b = 0; b < 2; ++b)
#pragma unroll
            for (int m = 0; m < 4; ++m)
#pragma unroll
                for (int n = 0; n < 2; ++n) acc[a][b][m][n] = (f32x4){0.f, 0.f, 0.f, 0.f};
    bf16x8 At[4][2], B0[2][2], B1[2][2];
    const char* cA = (const char*)g.A + (size_t)cur.pm * tstep; const char* cB = (const char*)g.Bt + (size_t)cur.pn * tstep;
    S.a_ready(cur);
    PG8_STAGE(PG8_SB(0, 0), cB, voffB); PG8_STAGE(PG8_SA(0, 0), cA, voffA); PG8_STAGE(PG8_SB(0, 1), cB + hstep, voffB); PG8_STAGE(PG8_SA(0, 1), cA + hstep, voffA);
    if (wr == 1) PG8_BAR;
    PG8_WAIT_V(4); PG8_BAR;
    PG8_STAGE(PG8_SB(1, 0), cB + kstep, voffB); PG8_STAGE(PG8_SA(1, 0), cA + kstep, voffA); PG8_STAGE(PG8_SB(1, 1), cB + hstep + kstep, voffB);
    PG8_WAIT_V(6); PG8_BAR;
    PG8_STAMP();
    for (;;) {
        const bool has_next = S.next(ui + 1, nxt);
        const char* nA = has_next ? (const char*)g.A + (size_t)nxt.pm * tstep : cA; const char* nB = has_next ? (const char*)g.Bt + (size_t)nxt.pn * tstep : cB;
        for (int t = 0; t < nt; t += 2) {
            const bool last = (t == nt - 2);
            const char* a1 = cA + (size_t)(t + 1) * kstep;
            const char* a2 = last ? nA : cA + (size_t)(t + 2) * kstep; const char* b2 = last ? nB : cB + (size_t)(t + 2) * kstep;
            const char* a3 = a2 + kstep; const char* b3 = b2 + kstep;
            if (last && has_next) S.a_ready(nxt);
            PG8_LDB(B0, 0, 0); PG8_SCHED; PG8_LDA(At, 0, 0); PG8_STAGE(PG8_SA(1, 1), a1 + hstep, voffA);
            PG8_WAIT_L(8); PG8_BAR; PG8_WAIT_L(0); PG8_MMA(0, 0, At, B0); PG8_BAR; PG8_SCHED;
            PG8_LDB(B1, 0, 1); PG8_STAGE(PG8_SB(0, 0), b2, voffB);
            PG8_BAR; PG8_WAIT_L(0); PG8_MMA(0, 1, At, B1); PG8_BAR;
            PG8_LDA(At, 0, 1); PG8_STAGE(PG8_SA(0, 0), a2, voffA);
            PG8_BAR; PG8_WAIT_L(0); PG8_MMA(1, 0, At, B0); PG8_BAR; PG8_SCHED;
            PG8_STAGE(PG8_SB(0, 1), b2 + hstep, voffB);
            PG8_WAIT_V(6); PG8_BAR; PG8_MMA(1, 1, At, B1); PG8_BAR;
            PG8_LDB(B0, 1, 0); PG8_SCHED; PG8_LDA(At, 1, 0); PG8_STAGE(PG8_SA(0, 1), a2 + hstep, voffA);
            PG8_WAIT_L(8); PG8_BAR; PG8_WAIT_L(0); PG8_MMA(0, 0, At, B0); PG8_BAR; PG8_SCHED;
            PG8_LDB(B1, 1, 1); PG8_STAGE(PG8_SB(1, 0), b3, voffB);
            PG8_BAR; PG8_WAIT_L(0); PG8_MMA(0, 1, At, B1); PG8_BAR;
            PG8_LDA(At, 1, 1); PG8_STAGE(PG8_SA(1, 0), a3, voffA);
            PG8_BAR; PG8_WAIT_L(0); PG8_MMA(1, 0, At, B0); PG8_BAR; PG8_SCHED;
            PG8_STAGE(PG8_SB(1, 1), b3 + hstep, voffB);
            PG8_WAIT_V(6); PG8_BAR; PG8_MMA(1, 1, At, B1); PG8_BAR;
        }
        PG8_STAMP();
        if constexpr (!Epi::AFTER_DRAIN) { E(acc, cur, wr, wc, fr, fq); S.done(cur); }
        PG8_STAMP();
        if (!has_next) break;
#pragma unroll
        for (int a = 0; a < 2; ++a)
#pragma unroll
            for (int b = 0; b < 2; ++b)
#pragma unroll
                for (int m = 0; m < 4; ++m)
#pragma unroll
                    for (int n = 0; n < 2; ++n) acc[a][b][m][n] = (f32x4){0.f, 0.f, 0.f, 0.f};
        cur = nxt; cA = nA; cB = nB; ++ui;
    }
    PG8_WAIT_V(0);
    if (wr == 0) PG8_BAR;
    PG8_BAR;
    if constexpr (Epi::AFTER_DRAIN) { E.fused(acc, cur, wr, wc, fr, fq, lds, wid, lane); S.done(cur); }
    PG8_STAMP();
    if (STAMP && wid == 0) { stamps[lane] = lane < nts ? (((unsigned long long)(unsigned)ts_hi << 32) | (unsigned)ts_lo) : 0ull;
        if (lane == 62) stamps[62] = rt_entry; if (lane == 63) stamps[63] = (unsigned long long)wall_clock64(); }
#undef PG8_STAMP
#undef PG8_SA
#undef PG8_SB
#undef PG8_STAGE
#undef PG8_LDA
#undef PG8_LDB
#undef PG8_MMA
#undef PG8_WAIT_V
#undef PG8_WAIT_L
#undef PG8_BAR
#undef PG8_SCHED
}
}

typedef unsigned short bf16;
typedef short bf16x8 __attribute__((ext_vector_type(8)));
typedef float f32x4 __attribute__((ext_vector_type(4)));
constexpr int SEQ = 16384, DM = 2048, INC = 11272, NPROJ = 11264, DFF = 8192;
constexpr float EPS = 1e-6f;
constexpr size_t MiB = (size_t)1 << 20;
constexpr size_t WS_IFP = 0;
constexpr size_t WS_KMEAN = 512 * 1024;
constexpr size_t WS_CNT = 768 * 1024;
constexpr size_t WS_FCH = 4 * MiB;
constexpr size_t WS_MLOC = 4 * MiB + 64 * 1024;
constexpr size_t WS_MPREV = 904 * 1024;
constexpr size_t WS_BAR = 960 * 1024;
constexpr size_t WS_NST = 1 * MiB;
constexpr size_t WS_NPREV = 1536 * 1024;
constexpr size_t WS_LSE = 2 * MiB;
constexpr size_t WS_WUP = 8 * MiB, WS_WDOWN = 40 * MiB, WS_WIN = 72 * MiB, WS_WBM = 116 * MiB, WS_WBA = 120 * MiB, WS_WOUT = 124 * MiB;
constexpr size_t WS_MQK = 132 * MiB;
constexpr size_t WS_MV = 196 * MiB, WS_MO = 228 * MiB, WS_AQ = 260 * MiB, WS_AK = 292 * MiB, WS_AV = 324 * MiB;
constexpr size_t WS_GM = 356 * MiB;
constexpr size_t WS_GA = 420 * MiB;
constexpr size_t WS_LIST = 484 * MiB;
constexpr size_t WS_U = 132 * MiB;
constexpr size_t WS_NEED = 500 * MiB;
constexpr int LDS_BYTES = 151552;

__device__ __forceinline__ float bf2f(unsigned short b) { return __uint_as_float(((unsigned)b) << 16); }
__device__ __forceinline__ unsigned short f2bf(float f) { unsigned u = __float_as_uint(f); u += 0x7fffu + ((u >> 16) & 1u); return (unsigned short)(u >> 16); }
__device__ __forceinline__ unsigned pk2(float lo, float hi) { return (unsigned)f2bf(lo) | ((unsigned)f2bf(hi) << 16); }
__device__ __forceinline__ float lo16(unsigned w) { return __uint_as_float(w << 16); }
__device__ __forceinline__ float hi16(unsigned w) { return __uint_as_float(w & 0xffff0000u); }
__device__ __forceinline__ float sigmoidf_(float x) { return 1.0f / (1.0f + __expf(-x)); }
__device__ __forceinline__ float logsigf_(float x) { return fminf(x, 0.f) - log1pf(expf(-fabsf(x))); }
__device__ __forceinline__ float wave_sum(float v) {
#pragma unroll
    for (int o = 1; o < 64; o <<= 1) v += __shfl_xor(v, o);
    return v; }
__device__ __forceinline__ float wave_max(float v) {
#pragma unroll
    for (int o = 1; o < 64; o <<= 1) v = fmaxf(v, __shfl_xor(v, o));
    return v; }
__device__ __forceinline__ float wave_incl_sum(float v, int lane) {
#pragma unroll
    for (int o = 1; o < 64; o <<= 1) { const float t = __shfl_up(v, o); if (lane >= o) v += t; }
    return v; }
__device__ __forceinline__ float wave_incl_max(float v, int lane) {
#pragma unroll
    for (int o = 1; o < 64; o <<= 1) { const float t = __shfl_up(v, o); if (lane >= o) v = fmaxf(v, t); }
    return v; }
__device__ __forceinline__ int wave_incl_sum_i(int v, int lane) {
#pragma unroll
    for (int o = 1; o < 64; o <<= 1) { const int t = __shfl_up(v, o); if (lane >= o) v += t; }
    return v; }
__device__ __forceinline__ f32x4 mma16(bf16x8 a, bf16x8 b, f32x4 c) { return __builtin_amdgcn_mfma_f32_16x16x32_bf16(a, b, c, 0, 0, 0); }
__device__ __forceinline__ void unpack8(const uint4 v, float (&f)[8]) { f[0] = lo16(v.x); f[1] = hi16(v.x); f[2] = lo16(v.y); f[3] = hi16(v.y); f[4] = lo16(v.z); f[5] = hi16(v.z); f[6] = lo16(v.w); f[7] = hi16(v.w); }
__device__ __forceinline__ uint4 pack8(const float (&f)[8]) { uint4 v; v.x = pk2(f[0], f[1]); v.y = pk2(f[2], f[3]); v.z = pk2(f[4], f[5]); v.w = pk2(f[6], f[7]); return v; }

struct Args { const void* in[17]; float* out; unsigned char* ws; int ph_lo, ph_hi; };
struct Ctx {
    unsigned char* lds; int tid, lane, wave, G, bid;
    const Args& a;
    float* out; unsigned char* ws;
};

__device__ __forceinline__ void p0_transpose_item(const float* W, int K, int ldw, int nblk, bool gap, bf16* WT, float* scr, int item, int lane) {
    const int kb = item / nblk, nb = item % nblk, k0 = 64 * kb, n0 = 32 * nb, n0s = n0 + ((gap && n0 >= 4096) ? 8 : 0);
#pragma unroll 8
    for (int i = 0; i < 32; ++i) { const int kk = 2 * i + (lane >> 5); scr[kk * 33 + (lane & 31)] = W[(size_t)(k0 + kk) * ldw + n0s + (lane & 31)]; }
    __builtin_amdgcn_s_waitcnt(0xc07f); asm volatile("" ::: "memory");
    const int c = lane & 7;
#pragma unroll
    for (int j = 0; j < 4; ++j) { const int n = (lane >> 3) + 8 * j; const float* s = scr + (8 * c) * 33 + n;
        uint4 o; o.x = pk2(s[0 * 33], s[1 * 33]); o.y = pk2(s[2 * 33], s[3 * 33]); o.z = pk2(s[4 * 33], s[5 * 33]); o.w = pk2(s[6 * 33], s[7 * 33]);
        *(uint4*)(WT + (size_t)(n0 + n) * K + k0 + 8 * c) = o; }
    __builtin_amdgcn_s_waitcnt(0xc07f); asm volatile("" ::: "memory");
}
__device__ __forceinline__ int wif_off(int k) { return k * 8 + (k >> 2) * 4; }
__device__ __forceinline__ void phase0(Ctx& C) {
    float* WIF = (float*)C.lds;
    for (int idx = C.tid; idx < 2048 * 8; idx += 512) { const int k = idx >> 3, j = idx & 7; WIF[wif_off(k) + j] = ((const float*)C.a.in[3])[(size_t)k * INC + 4096 + j]; }
    __syncthreads();
    const int gw = C.bid * 8 + C.wave, NGW = C.G * 8, lane = C.lane;
    bf16* XN = (bf16*)C.out; float* IFP = (float*)(C.ws + WS_IFP);
    for (int row = gw; row < SEQ; row += NGW) {
        const float4* xr = (const float4*)(((const float*)C.a.in[0]) + (size_t)row * DM) + lane; float ss = 0.f;
#pragma unroll
        for (int j = 0; j < 8; ++j) { const float4 v = xr[64 * j]; ss += (v.x * v.x + v.y * v.y) + (v.z * v.z + v.w * v.w); }
        const float rstd = rsqrtf(wave_sum(ss) * (1.f / DM) + EPS);
        float a8[8];
#pragma unroll
        for (int i = 0; i < 8; ++i) a8[i] = 0.f;
#pragma unroll 1
        for (int j = 0; j < 8; ++j) { const int k = 256 * j + 4 * lane; const float4 w = *(const float4*)(((const float*)C.a.in[2]) + k); const float4 v = xr[64 * j];
            float xn[4] = {v.x * rstd * w.x, v.y * rstd * w.y, v.z * rstd * w.z, v.w * rstd * w.w};
            uint2 o; o.x = pk2(xn[0], xn[1]); o.y = pk2(xn[2], xn[3]); *(uint2*)(XN + (size_t)row * DM + k) = o;
#pragma unroll
            for (int e = 0; e < 4; ++e) { const float4* wf = (const float4*)(WIF + wif_off(k + e)); const float4 w0 = wf[0], w1 = wf[1];
                a8[0] += xn[e] * w0.x; a8[1] += xn[e] * w0.y; a8[2] += xn[e] * w0.z; a8[3] += xn[e] * w0.w; a8[4] += xn[e] * w1.x; a8[5] += xn[e] * w1.y; a8[6] += xn[e] * w1.z; a8[7] += xn[e] * w1.w; } }
#pragma unroll
        for (int i = 0; i < 8; ++i) a8[i] = wave_sum(a8[i]);
        if (lane == 0) { float4* o = (float4*)(IFP + (size_t)row * 8); o[0] = make_float4(a8[0], a8[1], a8[2], a8[3]); o[1] = make_float4(a8[4], a8[5], a8[6], a8[7]); }
    }
    __syncthreads();
    float* scr = (float*)(C.lds + C.wave * 16384);
    constexpr int I_IN = 32 * 352, I_BM = 16 * 64, I_OUT = 32 * 64, I_UP = 32 * 256, I_DOWN = 128 * 64, NIT = I_IN + 2 * I_BM + I_OUT + I_UP + I_DOWN;
    for (int it = gw; it < NIT; it += NGW) { int r = it;
        if (r < I_IN) { p0_transpose_item(((const float*)C.a.in[3]), DM, INC, 352, true, (bf16*)(C.ws + WS_WIN), scr, r, lane); continue; } r -= I_IN;
        if (r < I_BM) { p0_transpose_item(((const float*)C.a.in[9]), 1024, DM, 64, false, (bf16*)(C.ws + WS_WBM), scr, r, lane); continue; } r -= I_BM;
        if (r < I_BM) { p0_transpose_item(((const float*)C.a.in[10]), 1024, DM, 64, false, (bf16*)(C.ws + WS_WBA), scr, r, lane); continue; } r -= I_BM;
        if (r < I_OUT) { p0_transpose_item(((const float*)C.a.in[11]), DM, DM, 64, false, (bf16*)(C.ws + WS_WOUT), scr, r, lane); continue; } r -= I_OUT;
        if (r < I_UP) { p0_transpose_item(((const float*)C.a.in[14]), DM, DFF, 256, false, (bf16*)(C.ws + WS_WUP), scr, r, lane); continue; } r -= I_UP;
        p0_transpose_item(((const float*)C.a.in[15]), DFF, DM, 64, false, (bf16*)(C.ws + WS_WDOWN), scr, r, lane); }
    __syncthreads();
}

__device__ __forceinline__ void phase2(Ctx& C) {
    const bf16* MQK = (const bf16*)(C.ws + WS_MQK); bf16* QKC = (bf16*)C.out;
    const int tid = C.tid;
    for (int item = C.bid; item < SEQ / 64; item += C.G) {
        const int half = tid >> 8, cg8 = (tid & 255) * 8, t0 = item * 64 + half * 32;
        float w[4][8], b[8];
#pragma unroll
        for (int j = 0; j < 4; ++j) { const float4 a = *(const float4*)(((const float*)C.a.in[4]) + j * 2048 + cg8), bb = *(const float4*)(((const float*)C.a.in[4]) + j * 2048 + cg8 + 4);
            w[j][0] = a.x; w[j][1] = a.y; w[j][2] = a.z; w[j][3] = a.w; w[j][4] = bb.x; w[j][5] = bb.y; w[j][6] = bb.z; w[j][7] = bb.w; }
        { const float4 a = *(const float4*)(((const float*)C.a.in[5]) + cg8), bb = *(const float4*)(((const float*)C.a.in[5]) + cg8 + 4); b[0] = a.x; b[1] = a.y; b[2] = a.z; b[3] = a.w; b[4] = bb.x; b[5] = bb.y; b[6] = bb.z; b[7] = bb.w; }
        float r0[8], r1[8], r2[8], cur[8];
#pragma unroll
        for (int i = 0; i < 8; ++i) { r0[i] = 0.f; r1[i] = 0.f; r2[i] = 0.f; }
        if (t0 >= 3) { unpack8(*(const uint4*)(MQK + (size_t)(t0 - 3) * 2048 + cg8), r0); unpack8(*(const uint4*)(MQK + (size_t)(t0 - 2) * 2048 + cg8), r1); unpack8(*(const uint4*)(MQK + (size_t)(t0 - 1) * 2048 + cg8), r2); }
        const float sc = (cg8 >= 1024) ? 0.0625f : 1.0f;
#pragma unroll 4
        for (int t = t0; t < t0 + 32; ++t) {
            unpack8(*(const uint4*)(MQK + (size_t)t * 2048 + cg8), cur);
            float o[8];
#pragma unroll
            for (int i = 0; i < 8; ++i) { const float y = b[i] + w[0][i] * r0[i] + w[1][i] * r1[i] + w[2][i] * r2[i] + w[3][i] * cur[i]; o[i] = y * sigmoidf_(y) * sc; r0[i] = r1[i]; r1[i] = r2[i]; r2[i] = cur[i]; }
            *(uint4*)(QKC + (size_t)t * 2048 + cg8) = pack8(o);
        }
    }
    bf16* AQ = (bf16*)(C.ws + WS_AQ); bf16* AK = (bf16*)(C.ws + WS_AK); float* KMEAN = (float*)(C.ws + WS_KMEAN);
    float* red = (float*)C.lds;
    const int tp = tid >> 3, dg = tid & 7;
    float invf[8];
#pragma unroll
    for (int i = 0; i < 8; ++i) invf[i] = 1.0f / powf(10000.0f, (float)(2 * (dg * 8 + i)) / 128.0f);
    for (int item = C.bid; item < 512; item += C.G) {
        const int h = item >> 6, n = item & 63;
        float ks1[8], ks2[8];
#pragma unroll
        for (int i = 0; i < 8; ++i) { ks1[i] = 0.f; ks2[i] = 0.f; }
        for (int pass = 0; pass < 4; ++pass) {
            const int t = n * 256 + pass * 64 + tp; const float p = (float)((const int*)C.a.in[1])[t];
            float cs[8], sn[8];
#pragma unroll
            for (int i = 0; i < 8; ++i) { const float ang = p * invf[i]; float s_, c_; sincosf(ang, &s_, &c_); sn[i] = s_; cs[i] = c_; }
            const size_t o1 = (size_t)t * 1024 + h * 128 + dg * 8, o2 = o1 + 64;
            float x1[8], x2[8], y1[8], y2[8];
            unpack8(*(const uint4*)(AQ + o1), x1); unpack8(*(const uint4*)(AQ + o2), x2);
#pragma unroll
            for (int i = 0; i < 8; ++i) { y1[i] = x1[i] * cs[i] - x2[i] * sn[i]; y2[i] = x2[i] * cs[i] + x1[i] * sn[i]; }
            *(uint4*)(AQ + o1) = pack8(y1); *(uint4*)(AQ + o2) = pack8(y2);
            unpack8(*(const uint4*)(AK + o1), x1); unpack8(*(const uint4*)(AK + o2), x2);
#pragma unroll
            for (int i = 0; i < 8; ++i) { y1[i] = x1[i] * cs[i] - x2[i] * sn[i]; y2[i] = x2[i] * cs[i] + x1[i] * sn[i]; ks1[i] += y1[i]; ks2[i] += y2[i]; }
            *(uint4*)(AK + o1) = pack8(y1); *(uint4*)(AK + o2) = pack8(y2);
        }
        __syncthreads();
#pragma unroll
        for (int i = 0; i < 8; ++i) { red[tp * 128 + dg * 8 + i] = ks1[i]; red[tp * 128 + 64 + dg * 8 + i] = ks2[i]; }
        __syncthreads();
        if (tid < 128) { float s = 0.f; for (int r = 0; r < 64; ++r) s += red[r * 128 + tid]; KMEAN[(size_t)item * 128 + tid] = s * (1.0f / 256.0f); }
    }
    __syncthreads();
}

__device__ __forceinline__ void gate_scalars(const Ctx& C, int c, int h, int lane, float& b0, float& b1, float& li0, float& li1) {
    const float* IFP = (const float*)(C.ws + WS_IFP);
    const float fb = ((const float*)C.a.in[7])[h], ib = ((const float*)C.a.in[6])[h];
    const float f0 = IFP[(size_t)(c * 128 + lane) * 8 + 4 + h] + fb, f1 = IFP[(size_t)(c * 128 + 64 + lane) * 8 + 4 + h] + fb;
    li0 = IFP[(size_t)(c * 128 + lane) * 8 + h] + ib; li1 = IFP[(size_t)(c * 128 + 64 + lane) * 8 + h] + ib;
    b0 = wave_incl_sum(logsigf_(f0), lane); const float tot0 = __shfl(b0, 63); b1 = wave_incl_sum(logsigf_(f1), lane) + tot0;
}
__device__ __forceinline__ void load_transposed_256(const bf16* src, int ld, bf16* Tt, const float* ev, int tid) {
    const int l = tid & 127, cgp = tid >> 7; const float el = ev ? ev[l] : 1.0f;
    const bf16* row = src + (size_t)l * ld;
#pragma unroll
    for (int i = 0; i < 8; ++i) { const int g = cgp * 8 + i; float f[8]; unpack8(*(const uint4*)(row + g * 8), f);
#pragma unroll
        for (int j = 0; j < 8; ++j) Tt[(g * 8 + j) * 136 + l] = f2bf(f[j] * el); }
}
__device__ __forceinline__ void mlstm_local_item(Ctx& C, int item) {
    const int c = item >> 2, h = item & 3, tid = C.tid, lane = C.lane, wave = C.wave, g = lane >> 4, tq = lane & 15;
    bf16* Vt = (bf16*)C.lds; bf16* Kt = Vt + 256 * 136; float* ev = (float*)(C.lds + 139264);
    const bf16* QKC = (const bf16*)C.out; bf16* CST = (bf16*)((unsigned char*)C.out + 64 * MiB); const bf16* MV = (const bf16*)(C.ws + WS_MV);
    if (wave == 0) {
        float b0, b1, li0, li1; gate_scalars(C, c, h, lane, b0, b1, li0, li1);
        const float F = __shfl(b1, 63); const float w0 = F - b0 + li0, w1 = F - b1 + li1; const float ml = wave_max(fmaxf(w0, w1));
        ev[lane] = expf(w0 - ml); ev[lane + 64] = expf(w1 - ml);
        if (lane == 0) { ((float*)(C.ws + WS_FCH))[item * 32] = F; ((float*)(C.ws + WS_MLOC))[item * 32] = ml; }
    }
    __syncthreads();
    load_transposed_256(MV + (size_t)(c * 128) * 1024 + h * 256, 1024, Vt, ev, tid);
    load_transposed_256(QKC + (size_t)(c * 128) * 2048 + 1024 + h * 256, 2048, Kt, nullptr, tid);
    __syncthreads();
#pragma unroll 1
    for (int nh = 0; nh < 2; ++nh) {
        f32x4 acc[2][8];
#pragma unroll
        for (int mi = 0; mi < 2; ++mi)
#pragma unroll
            for (int ni = 0; ni < 8; ++ni) acc[mi][ni] = (f32x4){0.f, 0.f, 0.f, 0.f};
#pragma unroll
        for (int ks = 0; ks < 4; ++ks) {
            bf16x8 a[2];
#pragma unroll
            for (int mi = 0; mi < 2; ++mi) a[mi] = *(const bf16x8*)(Kt + (32 * wave + mi * 16 + tq) * 136 + ks * 32 + 8 * g);
#pragma unroll
            for (int ni = 0; ni < 8; ++ni) { const bf16x8 b = *(const bf16x8*)(Vt + ((nh * 8 + ni) * 16 + tq) * 136 + ks * 32 + 8 * g);
#pragma unroll
                for (int mi = 0; mi < 2; ++mi) acc[mi][ni] = mma16(a[mi], b, acc[mi][ni]); }
        }
#pragma unroll
        for (int mi = 0; mi < 2; ++mi)
#pragma unroll
            for (int ni = 0; ni < 8; ++ni) { uint2 o; o.x = pk2(acc[mi][ni][0], acc[mi][ni][1]); o.y = pk2(acc[mi][ni][2], acc[mi][ni][3]);
#ifdef EXP_K
                o.x = pk2(0.01f, 0.02f); o.y = pk2(-0.01f, 0.005f);
#endif
                __hip_atomic_store((unsigned long long*)(CST + ((size_t)item * 256 + (nh * 8 + ni) * 16 + tq) * 256 + 32 * wave + mi * 16 + 4 * g), ((unsigned long long)o.y << 32) | o.x, __ATOMIC_RELAXED, __HIP_MEMORY_SCOPE_AGENT); }
    }
    if (tid < 256) { float s = 0.f; const bf16* kr = Kt + tid * 136;
        for (int l8 = 0; l8 < 16; ++l8) { float f[8]; unpack8(*(const uint4*)(kr + l8 * 8), f);
#pragma unroll
            for (int j = 0; j < 8; ++j) s += f[j] * ev[l8 * 8 + j]; }
        __hip_atomic_store((unsigned*)(C.ws + WS_NST) + (size_t)item * 256 + tid, __float_as_uint(s), __ATOMIC_RELAXED, __HIP_MEMORY_SCOPE_AGENT); }
    __syncthreads();
}
__device__ __forceinline__ void mlstm_scan(Ctx& C) {
    const float* FCH = (const float*)(C.ws + WS_FCH); const float* MLOC = (const float*)(C.ws + WS_MLOC); float* MPREV = (float*)(C.ws + WS_MPREV);
    const bf16* CST = (const bf16*)((unsigned char*)C.out + 64 * MiB); const float* NST = (const float*)(C.ws + WS_NST); bf16* CPV = (bf16*)(C.ws + WS_MQK); float* NPV = (float*)(C.ws + WS_NPREV);
    for (int item = C.bid; item < 129; item += C.G) {
        if (item < 128) {
            const int e = item * 512 + C.tid, h = e >> 14, off = (e & 16383) * 4;
            float st[4] = {0.f, 0.f, 0.f, 0.f}; float m = 0.f;
            const bf16* p = CST + (size_t)h * 65536 + off; bf16* pw = CPV + (size_t)h * 65536 + off;
            for (int c0 = 0; c0 < 128; c0 += 8) {
                uint2 ld[8];
#pragma unroll
                for (int j = 0; j < 8; ++j) ld[j] = *(const uint2*)(p + (size_t)(c0 + j) * 4 * 65536);
#pragma unroll
                for (int j = 0; j < 8; ++j) { const int c = c0 + j; const float Fc = FCH[(c * 4 + h) * 32], ml = MLOC[(c * 4 + h) * 32];
                    uint2 o; o.x = pk2(st[0], st[1]); o.y = pk2(st[2], st[3]); *(uint2*)(pw + (size_t)c * 4 * 65536) = o;
                    const float mn = fmaxf(Fc + m, ml), a = expf(Fc + m - mn), gg = expf(ml - mn);
                    st[0] = a * st[0] + gg * lo16(ld[j].x); st[1] = a * st[1] + gg * hi16(ld[j].x); st[2] = a * st[2] + gg * lo16(ld[j].y); st[3] = a * st[3] + gg * hi16(ld[j].y); m = mn; }
            }
        } else {
#pragma unroll
            for (int rep = 0; rep < 2; ++rep) { const int el = C.tid + rep * 512, h = el >> 8; float st = 0.f, m = 0.f;
                for (int c = 0; c < 128; ++c) { const float Fc = FCH[(c * 4 + h) * 32], ml = MLOC[(c * 4 + h) * 32]; const size_t qi = (size_t)(c * 4 + h) * 256 + (el & 255); const float nl = NST[qi]; NPV[qi] = st;
                    if ((el & 255) == 0) MPREV[c * 4 + h] = m;
                    const float mn = fmaxf(Fc + m, ml), a = expf(Fc + m - mn), gg = expf(ml - mn); st = a * st + gg * nl; m = mn; } }
        }
    }
}
__device__ __forceinline__ void mlstm_num1_item(Ctx& C, int item) {
    const int c = item >> 2, h = item & 3, tid = C.tid, lane = C.lane, wave = C.wave, g = lane >> 4, tq = lane & 15;
    bf16* Cs = (bf16*)C.lds;
    const bf16* QKC = (const bf16*)C.out; const bf16* CPV = (const bf16*)(C.ws + WS_MQK); bf16* NUM1 = (bf16*)(C.ws + WS_WIN);
    bf16x8 qf[8];
    { const bf16* qrow = QKC + (size_t)(c * 128 + 16 * wave + tq) * 2048 + h * 256 + 8 * g;
#pragma unroll
      for (int ks = 0; ks < 8; ++ks) qf[ks] = *(const bf16x8*)(qrow + ks * 32); }
#pragma unroll 1
    for (int hv = 0; hv < 2; ++hv) {
        __syncthreads();
#pragma unroll
        for (int i = 0; i < 8; ++i) { const int idx = tid + i * 512, row = idx >> 5, ch = idx & 31;
            *(uint4*)(Cs + row * 264 + ch * 8) = *(const uint4*)(CPV + (size_t)item * 65536 + (size_t)(hv * 128 + row) * 256 + ch * 8); }
        __syncthreads();
        f32x4 o[8];
#pragma unroll
        for (int ni = 0; ni < 8; ++ni) { o[ni] = (f32x4){0.f, 0.f, 0.f, 0.f};
#pragma unroll
            for (int ks = 0; ks < 8; ++ks) { const bf16x8 cf = *(const bf16x8*)(Cs + (ni * 16 + tq) * 264 + ks * 32 + 8 * g); o[ni] = mma16(qf[ks], cf, o[ni]); } }
#pragma unroll
        for (int ni = 0; ni < 8; ++ni)
#pragma unroll
            for (int r = 0; r < 4; ++r) NUM1[(size_t)(c * 128 + 16 * wave + 4 * g + r) * 1024 + h * 256 + hv * 128 + ni * 16 + tq] = f2bf(o[ni][r]);
    }
    asm volatile("s_waitcnt vmcnt(0)" ::: "memory");
    __syncthreads();
}
__device__ __forceinline__ void mlstm_out_item(Ctx& C, int item) {
    const int c = item >> 2, h = item & 3, tid = C.tid, lane = C.lane, wave = C.wave, g = lane >> 4, tq = lane & 15;
    bf16* Ks = (bf16*)C.lds; bf16* Vt = (bf16*)(C.lds + 67584); float* sc = (float*)(C.lds + 137216); const bf16* NUM1 = (const bf16*)(C.ws + WS_WIN);
    float* negmx = sc, *lib = sc + 128, *inter = sc + 256, *emt = sc + 384, *npv = sc + 512, *dens = sc + 768;
    const bf16* QKC = (const bf16*)C.out;
#ifdef EXP_F
    const bf16* CST = (const bf16*)((unsigned char*)C.out + 64 * MiB);
#else
    const bf16* CST = (const bf16*)(C.ws + WS_MQK);
#endif
 const bf16* MV = (const bf16*)(C.ws + WS_MV); bf16* MO = (bf16*)(C.ws + WS_MO);
    if (wave == 0) {
        const float mp = ((const float*)(C.ws + WS_MPREV))[item];
        float b0, b1, li0, li1; gate_scalars(C, c, h, lane, b0, b1, li0, li1);
        const float x0 = li0 - b0, x1 = li1 - b1; const float cm0 = wave_incl_max(x0, lane); const float t0 = __shfl(cm0, 63); const float cm1 = fmaxf(wave_incl_max(x1, lane), t0);
        const float M0 = fmaxf(mp, cm0), M1 = fmaxf(mp, cm1);
        negmx[lane] = -M0; negmx[lane + 64] = -M1; lib[lane] = x0; lib[lane + 64] = x1; inter[lane] = expf(mp - M0); inter[lane + 64] = expf(mp - M1);
        emt[lane] = expf(-(b0 + M0)); emt[lane + 64] = expf(-(b1 + M1));
    }
    if (tid < 256) npv[tid] = ((const float*)(C.ws + WS_NPREV))[(size_t)item * 256 + tid];
#pragma unroll
    for (int i = 0; i < 8; ++i) { const int idx = tid + i * 512, row = idx >> 5, ch = idx & 31;
        *(uint4*)(Ks + row * 264 + ch * 8) = *(const uint4*)(QKC + (size_t)(c * 128 + row) * 2048 + 1024 + h * 256 + ch * 8); }
    load_transposed_256(MV + (size_t)(c * 128) * 1024 + h * 256, 1024, Vt, nullptr, tid);
    __syncthreads();
    const int t = 16 * wave + tq;
    bf16x8 qf[8];
    { const bf16* qrow = QKC + (size_t)(c * 128 + t) * 2048 + h * 256 + 8 * g;
#pragma unroll
      for (int ks = 0; ks < 8; ++ks) qf[ks] = *(const bf16x8*)(qrow + ks * 32); }
    f32x4 sacc[8];
#pragma unroll
    for (int mi = 0; mi < 8; ++mi) sacc[mi] = (f32x4){0.f, 0.f, 0.f, 0.f};
#pragma unroll
    for (int mi = 0; mi < 8; ++mi) if (mi <= wave) {
#pragma unroll
        for (int ks = 0; ks < 8; ++ks) { const bf16x8 a = *(const bf16x8*)(Ks + (mi * 16 + tq) * 264 + ks * 32 + 8 * g); sacc[mi] = mma16(a, qf[ks], sacc[mi]); } }
    const float nm = negmx[t]; float rs = 0.f;
#pragma unroll
    for (int mi = 0; mi < 8; ++mi)
#pragma unroll
        for (int r = 0; r < 4; ++r) { const int s = mi * 16 + 4 * g + r; const float p = (s <= t) ? sacc[mi][r] * __expf(nm + lib[s]) : 0.f; rs += p; sacc[mi][r] = p; }
    rs += __shfl_xor(rs, 16); rs += __shfl_xor(rs, 32);
    float qn = 0.f;
#pragma unroll
    for (int ks = 0; ks < 8; ++ks)
#pragma unroll
        for (int j = 0; j < 8; ++j) qn += bf2f((unsigned short)qf[ks][j]) * npv[ks * 32 + 8 * g + j];
    qn += __shfl_xor(qn, 16); qn += __shfl_xor(qn, 32);
    { const float den = inter[t] * qn + rs; const float dn = fmaxf(fabsf(den), emt[t]); if (g == 0) dens[t] = dn; }
    f32x4 o[16];
#pragma unroll
    for (int ni = 0; ni < 16; ++ni) o[ni] = (f32x4){0.f, 0.f, 0.f, 0.f};
    float itr[4], dr[4];
#pragma unroll
    for (int r = 0; r < 4; ++r) { itr[r] = inter[16 * wave + 4 * g + r]; dr[r] = 1.0f / dens[16 * wave + 4 * g + r]; }
    { const bf16* n1p = NUM1 + (size_t)(c * 128 + 16 * wave + 4 * g) * 1024 + h * 256 + tq;
#pragma unroll
      for (int ni = 0; ni < 16; ++ni)
#pragma unroll
          for (int r = 0; r < 4; ++r) o[ni][r] = itr[r] * bf2f(n1p[r * 1024 + ni * 16]); }

#pragma unroll
    for (int i = 0; i < 4; ++i) if (2 * i <= wave) {
        bf16x8 pa; { const unsigned a0 = pk2(sacc[2 * i][0], sacc[2 * i][1]), a1 = pk2(sacc[2 * i][2], sacc[2 * i][3]), a2 = pk2(sacc[2 * i + 1][0], sacc[2 * i + 1][1]), a3 = pk2(sacc[2 * i + 1][2], sacc[2 * i + 1][3]);
            const uint4 u = make_uint4(a0, a1, a2, a3); pa = __builtin_bit_cast(bf16x8, u); }
#pragma unroll
        for (int ni = 0; ni < 16; ++ni) { const bf16* vp = Vt + (ni * 16 + tq) * 136 + 32 * i + 4 * g; const uint2 lo = *(const uint2*)vp, hi = *(const uint2*)(vp + 16);
            const uint4 u = make_uint4(lo.x, lo.y, hi.x, hi.y); o[ni] = mma16(pa, __builtin_bit_cast(bf16x8, u), o[ni]); } }
    float ss[4] = {0.f, 0.f, 0.f, 0.f};
#pragma unroll
    for (int ni = 0; ni < 16; ++ni)
#pragma unroll
        for (int r = 0; r < 4; ++r) { o[ni][r] *= dr[r]; ss[r] += o[ni][r] * o[ni][r]; }
#pragma unroll
    for (int r = 0; r < 4; ++r) { ss[r] += __shfl_xor(ss[r], 1); ss[r] += __shfl_xor(ss[r], 2); ss[r] += __shfl_xor(ss[r], 4); ss[r] += __shfl_xor(ss[r], 8); ss[r] = rsqrtf(ss[r] * (1.0f / 256.0f) + EPS); }
#pragma unroll
    for (int ni = 0; ni < 16; ++ni) { const int v = ni * 16 + tq; const float gam = ((const float*)C.a.in[8])[h * 256 + v];
#pragma unroll
        for (int r = 0; r < 4; ++r) { bf16* p = MO + (size_t)(c * 128 + 16 * wave + 4 * g + r) * 1024 + h * 256 + v; const float mo = bf2f(*p);
#ifdef HM_GATE_ONLY
            *p = f2bf(gam * sigmoidf_(mo));
#else
            *p = f2bf(o[ni][r] * ss[r] * gam * sigmoidf_(mo));
#endif
        } }
    __syncthreads();
}

__device__ __forceinline__ void moba_select_item(Ctx& C, int item) {
    const int h = item >> 6, qb = item & 63, own = qb, tid = C.tid;
    int* CNT = (int*)(C.ws + WS_CNT); unsigned short* LIST = (unsigned short*)(C.ws + WS_LIST);
    if (own == 0) { if (tid < 64) CNT[(h * 64 + qb) * 64 + tid] = 0; return; }
    bf16* Qs = (bf16*)C.lds; float* KM = (float*)(C.lds + 69632); int* cnt = (int*)(C.lds + 102400); float* cand = (float*)(C.lds + 102656);
    const bf16* AQ = (const bf16*)(C.ws + WS_AQ); const float* KMEAN = (const float*)(C.ws + WS_KMEAN);
#pragma unroll
    for (int i = 0; i < 8; ++i) { const int idx = tid + i * 512, row = idx >> 4, ch = idx & 15; *(uint4*)(Qs + row * 136 + ch * 8) = *(const uint4*)(AQ + (size_t)(qb * 256 + row) * 1024 + h * 128 + ch * 8); }
    for (int idx = tid; idx < own * 32; idx += 512) ((float4*)KM)[idx] = ((const float4*)(KMEAN + (size_t)h * 64 * 128))[idx];
    if (tid < 64) cnt[tid] = 0;
    __syncthreads();
    const int q = tid & 255, half = tid >> 8, nb = half * 32;
    float ga[32];
#pragma unroll
    for (int nn = 0; nn < 32; ++nn) ga[nn] = 0.f;
#pragma unroll 1
    for (int d0 = 0; d0 < 128; d0 += 8) { float qv[8]; unpack8(*(const uint4*)(Qs + q * 136 + d0), qv);
#pragma unroll
        for (int nn = 0; nn < 32; ++nn) if (nb + nn < own) { const float4 k0 = *(const float4*)(KM + (nb + nn) * 128 + d0), k1 = *(const float4*)(KM + (nb + nn) * 128 + d0 + 4);
            ga[nn] += (qv[0] * k0.x + qv[1] * k0.y + qv[2] * k0.z + qv[3] * k0.w) + (qv[4] * k1.x + qv[5] * k1.y + qv[6] * k1.z + qv[7] * k1.w);
            if ((nn & 3) == 3) asm volatile("" ::: "memory"); } }
    const float NINF = -__builtin_inff();
    float v1 = NINF, v2 = NINF, v3 = NINF; int i1 = -1, i2 = -1, i3 = -1;
#define TOP3_INS(x, n) do { if ((x) > v1) { v3 = v2; i3 = i2; v2 = v1; i2 = i1; v1 = (x); i1 = (n); } else if ((x) > v2) { v3 = v2; i3 = i2; v2 = (x); i2 = (n); } else if ((x) > v3) { v3 = (x); i3 = (n); } } while (0)
#pragma unroll
    for (int nn = 0; nn < 32; ++nn) if (nb + nn < own) { const float xv = ga[nn]; TOP3_INS(xv, nb + nn); }
    cand[tid * 6 + 0] = v1; cand[tid * 6 + 1] = __int_as_float(i1); cand[tid * 6 + 2] = v2; cand[tid * 6 + 3] = __int_as_float(i2); cand[tid * 6 + 4] = v3; cand[tid * 6 + 5] = __int_as_float(i3);
    __syncthreads();
    if (half == 0) {
#pragma unroll
        for (int j = 0; j < 3; ++j) { const float xv = cand[(tid + 256) * 6 + 2 * j]; const int xi = __float_as_int(cand[(tid + 256) * 6 + 2 * j + 1]); if (xi >= 0) TOP3_INS(xv, xi); }
        const int sel[3] = {i1, i2, i3};
#pragma unroll
        for (int j = 0; j < 3; ++j) if (sel[j] >= 0) { const int pos = atomicAdd(&cnt[sel[j]], 1); LIST[((size_t)(h * 64 + sel[j]) * 64 + qb) * 256 + pos] = (unsigned short)((q << 2) | j); }
    }
#undef TOP3_INS
    __syncthreads();
    if (tid < 64) CNT[(h * 64 + qb) * 64 + tid] = (tid < own) ? cnt[tid] : 0;
    __syncthreads();
}
__device__ __forceinline__ void moba_tile(Ctx& C, int h, int n, bool is_own, int arg, int& cached_hn) {
    const int tid = C.tid, lane = C.lane, wave = C.wave, g = lane >> 4, tq = lane & 15, hn = h * 64 + n;
    bf16* Ks = (bf16*)C.lds; bf16* Vt = (bf16*)(C.lds + 69632); int* segp = (int*)(C.lds + 137216 + 2048); int* rowq = segp + 72; int* rowslot = rowq + 128;
    const bf16* AQ = (const bf16*)(C.ws + WS_AQ); const bf16* AK = (const bf16*)(C.ws + WS_AK); const bf16* AV = (const bf16*)(C.ws + WS_AV);
    const int* CNT = (const int*)(C.ws + WS_CNT); const unsigned short* LIST = (const unsigned short*)(C.ws + WS_LIST);
    bf16* PART = (bf16*)C.out; float* LSE = (float*)(C.ws + WS_LSE);
    const bool reload = (hn != cached_hn);
    __syncthreads();
    if (reload) {
#pragma unroll
        for (int i = 0; i < 8; ++i) { const int idx = tid + i * 512, row = idx >> 4, ch = idx & 15; *(uint4*)(Ks + row * 136 + ch * 8) = *(const uint4*)(AK + (size_t)(n * 256 + row) * 1024 + h * 128 + ch * 8); }
        { const int key = tid & 255, dgp = tid >> 8; const bf16* vrow = AV + (size_t)(n * 256 + key) * 1024 + h * 128;
#pragma unroll
          for (int i = 0; i < 8; ++i) { const int dg = dgp * 8 + i; const uint4 vv = *(const uint4*)(vrow + dg * 8); const unsigned wv[4] = {vv.x, vv.y, vv.z, vv.w};
#pragma unroll
              for (int j = 0; j < 8; ++j) Vt[(dg * 8 + j) * 264 + key] = (unsigned short)((j & 1) ? (wv[j >> 1] >> 16) : (wv[j >> 1] & 0xffffu)); } }
        if (wave == 0) { const int cv = CNT[(h * 64 + lane) * 64 + n]; const int inc = wave_incl_sum_i(cv, lane); segp[lane] = inc - cv; if (lane == 63) segp[64] = inc; }
        cached_hn = hn;
    }
    __syncthreads();
    if (tid < 128) {
        if (is_own) { rowq[tid] = arg * 128 + tid; rowslot[tid] = 3; }
        else { const int p = arg * 128 + tid, tot = segp[64]; int rq = -1, rsl = 0;
            if (p < tot) { int lo = 0, hi = 64; while (hi - lo > 1) { const int mid = (lo + hi) >> 1; if (segp[mid] <= p) lo = mid; else hi = mid; }
                const unsigned e = LIST[((size_t)hn * 64 + lo) * 256 + (p - segp[lo])]; rq = lo * 256 + (int)(e >> 2); rsl = (int)(e & 3u); }
            rowq[tid] = rq; rowslot[tid] = rsl; }
    }
    __syncthreads();
    const int qi = rowq[16 * wave + tq], ql = qi < 0 ? 0 : qi;
    bf16x8 qf[4];
    { const bf16* qrow = AQ + (size_t)ql * 1024 + h * 128 + 8 * g;
#pragma unroll
      for (int ks = 0; ks < 4; ++ks) qf[ks] = *(const bf16x8*)(qrow + ks * 32); }
    f32x4 sacc[16];
#pragma unroll
    for (int mi = 0; mi < 16; ++mi) { sacc[mi] = (f32x4){0.f, 0.f, 0.f, 0.f};
#pragma unroll
        for (int ks = 0; ks < 4; ++ks) { const bf16x8 a = *(const bf16x8*)(Ks + (mi * 16 + tq) * 136 + ks * 32 + 8 * g); sacc[mi] = mma16(a, qf[ks], sacc[mi]); } }
    const float scale = 0.08838834764831845f; const int qloc = is_own ? (ql - n * 256) : 100000; float mx = -__builtin_inff();
#pragma unroll
    for (int mi = 0; mi < 16; ++mi)
#pragma unroll
        for (int r = 0; r < 4; ++r) { const int key = mi * 16 + 4 * g + r; float s = sacc[mi][r] * scale; if (key > qloc) s = -__builtin_inff(); sacc[mi][r] = s; mx = fmaxf(mx, s); }
    mx = fmaxf(mx, __shfl_xor(mx, 16)); mx = fmaxf(mx, __shfl_xor(mx, 32));
    float l = 0.f;
#pragma unroll
    for (int mi = 0; mi < 16; ++mi)
#pragma unroll
        for (int r = 0; r < 4; ++r) { const float p = __expf(sacc[mi][r] - mx); l += p; sacc[mi][r] = p; }
    l += __shfl_xor(l, 16); l += __shfl_xor(l, 32);
    f32x4 o[8];
#pragma unroll
    for (int ni = 0; ni < 8; ++ni) o[ni] = (f32x4){0.f, 0.f, 0.f, 0.f};
#pragma unroll
    for (int i = 0; i < 8; ++i) {
        bf16x8 pa; { const uint4 u = make_uint4(pk2(sacc[2 * i][0], sacc[2 * i][1]), pk2(sacc[2 * i][2], sacc[2 * i][3]), pk2(sacc[2 * i + 1][0], sacc[2 * i + 1][1]), pk2(sacc[2 * i + 1][2], sacc[2 * i + 1][3])); pa = __builtin_bit_cast(bf16x8, u); }
#pragma unroll
        for (int ni = 0; ni < 8; ++ni) { const bf16* vp = Vt + (ni * 16 + tq) * 264 + 32 * i + 4 * g; const uint2 lo = *(const uint2*)vp, hi = *(const uint2*)(vp + 16);
            const uint4 u = make_uint4(lo.x, lo.y, hi.x, hi.y); o[ni] = mma16(pa, __builtin_bit_cast(bf16x8, u), o[ni]); } }
#pragma unroll
    for (int r = 0; r < 4; ++r) { const float lr = __shfl(l, 4 * g + r); const float inv = 1.0f / lr; const int qr = rowq[16 * wave + 4 * g + r], sl = rowslot[16 * wave + 4 * g + r];
        if (qr >= 0) { bf16* dst = PART + ((size_t)(qr * 8 + h) * 4 + sl) * 128 + tq;
#pragma unroll
            for (int ni = 0; ni < 8; ++ni) dst[ni * 16] = f2bf(o[ni][r] * inv); } }
    if (g == 0 && qi >= 0) __hip_atomic_store((unsigned*)LSE + (size_t)(qi * 8 + h) * 4 + rowslot[16 * wave + tq], __float_as_uint(mx + __logf(l)), __ATOMIC_RELAXED, __HIP_MEMORY_SCOPE_AGENT);
}
__device__ __forceinline__ void moba_attn(Ctx& C) {
    const int tid = C.tid, lane = C.lane, wave = C.wave;
    int* incl = (int*)(C.lds + 137216); int* wtot = incl + 512 + 72 + 256;
    const int* CNT = (const int*)(C.ws + WS_CNT);
    { int tot = 0; const int* cp = CNT + (tid >> 6) * 4096 + (tid & 63);
#pragma unroll 8
      for (int qb = 0; qb < 64; ++qb) tot += cp[qb * 64];
      const int nt = (tot + 127) >> 7; const int v = wave_incl_sum_i(nt, lane); if (lane == 63) wtot[wave] = v; __syncthreads();
      int off = 0; for (int w = 0; w < wave; ++w) off += wtot[w]; incl[tid] = v + off; __syncthreads(); }
    const int T = incl[511]; int cached = -1;
    for (int it = C.bid; it < 1024; it += C.G) { const int h = it >> 7, qt = it & 127; moba_tile(C, h, qt >> 1, true, qt, cached); }
    const int f0 = (int)(((long)C.bid * T) / C.G), f1 = (int)(((long)(C.bid + 1) * T) / C.G);
    for (int f = f0; f < f1; ++f) {
        int lo = 0, hi = 511;
        while (lo < hi) { const int mid = (lo + hi) >> 1; if (incl[mid] > f) hi = mid; else lo = mid + 1; }
        const int hn = lo; const int excl = hn ? incl[hn - 1] : 0;
        moba_tile(C, hn >> 6, hn & 63, false, f - excl, cached);
    }
    __syncthreads();
}
__device__ __forceinline__ void moba_combine(Ctx& C) {
    const bf16* PART = (const bf16*)C.out; const float* LSE = (const float*)(C.ws + WS_LSE); bf16* HA = (bf16*)(C.ws + WS_AQ);
    const int total = SEQ * 8 * 16;
    for (int idx = C.bid * 512 + C.tid; idx < total; idx += C.G * 512) {
        const int dg = idx & 15, h = (idx >> 4) & 7, q = idx >> 7; const int nsel = min(q >> 8, 3);
        const float4 ls = *(const float4*)(LSE + (size_t)(q * 8 + h) * 4); const float lv[4] = {ls.x, ls.y, ls.z, ls.w};
        float M = lv[3];
#pragma unroll
        for (int j = 0; j < 3; ++j) if (j < nsel) M = fmaxf(M, lv[j]);
        float acc[8], wsum = 0.f;
#pragma unroll
        for (int i = 0; i < 8; ++i) acc[i] = 0.f;
#pragma unroll
        for (int j = 0; j < 4; ++j) if (j == 3 || j < nsel) { const float w = __expf(lv[j] - M); wsum += w; float f[8]; unpack8(*(const uint4*)(PART + ((size_t)(q * 8 + h) * 4 + j) * 128 + dg * 8), f);
#pragma unroll
            for (int i = 0; i < 8; ++i) acc[i] += w * f[i]; }
        const float inv = 1.0f / wsum;
#pragma unroll
        for (int i = 0; i < 8; ++i) acc[i] *= inv;
#ifdef ZERO_HA
#pragma unroll
        for (int i = 0; i < 8; ++i) acc[i] = 0.f;
#endif
        *(uint4*)(HA + (size_t)q * 1024 + h * 128 + dg * 8) = pack8(acc);
    }
}

__device__ __forceinline__ void rows1(Ctx& C) {
    const bf16* MIX = (const bf16*)(C.ws + WS_GM); bf16* HN = (bf16*)(C.ws + WS_GA);
    const int gw = C.bid * 8 + C.wave, NGW = C.G * 8, lane = C.lane;
    for (int row = gw; row < SEQ; row += NGW) {
        float m[4][8]; float ss = 0.f;
#pragma unroll
        for (int j = 0; j < 4; ++j) { unpack8(*(const uint4*)(MIX + (size_t)row * DM + 512 * j + 8 * lane), m[j]);
#pragma unroll
            for (int i = 0; i < 8; ++i) ss += m[j][i] * m[j][i]; }
        const float rstd = rsqrtf(wave_sum(ss) * (1.f / DM) + EPS); float ss2 = 0.f;
#ifdef ZERO_MIX
#pragma unroll
        for (int j = 0; j < 4; ++j)
#pragma unroll
            for (int i = 0; i < 8; ++i) m[j][i] = 0.f;
#endif
#pragma unroll
        for (int j = 0; j < 4; ++j) { const int k = 512 * j + 8 * lane; const float4* xp = (const float4*)(((const float*)C.a.in[0]) + (size_t)row * DM + k); const float4* wp = (const float4*)(((const float*)C.a.in[12]) + k);
            const float4 xa = xp[0], xb = xp[1], wa = wp[0], wb = wp[1];
            m[j][0] = xa.x + m[j][0] * rstd * wa.x; m[j][1] = xa.y + m[j][1] * rstd * wa.y; m[j][2] = xa.z + m[j][2] * rstd * wa.z; m[j][3] = xa.w + m[j][3] * rstd * wa.w;
            m[j][4] = xb.x + m[j][4] * rstd * wb.x; m[j][5] = xb.y + m[j][5] * rstd * wb.y; m[j][6] = xb.z + m[j][6] * rstd * wb.z; m[j][7] = xb.w + m[j][7] * rstd * wb.w;
            float4* op = (float4*)(C.out + (size_t)row * DM + k); op[0] = make_float4(m[j][0], m[j][1], m[j][2], m[j][3]); op[1] = make_float4(m[j][4], m[j][5], m[j][6], m[j][7]);
#pragma unroll
            for (int i = 0; i < 8; ++i) ss2 += m[j][i] * m[j][i]; }
        const float rstd2 = rsqrtf(wave_sum(ss2) * (1.f / DM) + EPS);
#pragma unroll
        for (int j = 0; j < 4; ++j) { const int k = 512 * j + 8 * lane; const float4* wp = (const float4*)(((const float*)C.a.in[13]) + k); const float4 wa = wp[0], wb = wp[1];
            float o[8] = {m[j][0] * rstd2 * wa.x, m[j][1] * rstd2 * wa.y, m[j][2] * rstd2 * wa.z, m[j][3] * rstd2 * wa.w, m[j][4] * rstd2 * wb.x, m[j][5] * rstd2 * wb.y, m[j][6] * rstd2 * wb.z, m[j][7] * rstd2 * wb.w};
            *(uint4*)(HN + (size_t)row * DM + k) = pack8(o); }
    }
}
__device__ __forceinline__ void rows2(Ctx& C) {
    const bf16* Y = (const bf16*)(C.ws + WS_GA);
    const int gw = C.bid * 8 + C.wave, NGW = C.G * 8, lane = C.lane;
    for (int row = gw; row < SEQ; row += NGW) {
        float m[4][8]; float ss = 0.f;
#pragma unroll
        for (int j = 0; j < 4; ++j) { unpack8(*(const uint4*)(Y + (size_t)row * DM + 512 * j + 8 * lane), m[j]);
#pragma unroll
            for (int i = 0; i < 8; ++i) ss += m[j][i] * m[j][i]; }
        const float rstd = rsqrtf(wave_sum(ss) * (1.f / DM) + EPS);
#pragma unroll
        for (int j = 0; j < 4; ++j) { const int k = 512 * j + 8 * lane; float4* op = (float4*)(C.out + (size_t)row * DM + k); const float4* wp = (const float4*)(((const float*)C.a.in[16]) + k);
            const float4 xa = op[0], xb = op[1], wa = wp[0], wb = wp[1];
            op[0] = make_float4(xa.x + m[j][0] * rstd * wa.x, xa.y + m[j][1] * rstd * wa.y, xa.z + m[j][2] * rstd * wa.z, xa.w + m[j][3] * rstd * wa.w);
            op[1] = make_float4(xb.x + m[j][4] * rstd * wb.x, xb.y + m[j][5] * rstd * wb.y, xb.z + m[j][6] * rstd * wb.z, xb.w + m[j][7] * rstd * wb.w); }
    }
}


#define XB_TMO      128
#define XB_XCNT(j)  (256  + 64 * (j))
#define XB_XSUB(j)  (1280 + 64 * (j))
#define XB_XGEN(j)  (2304 + 64 * (j))
#define XB_TOP      3328
#define XB_TOPGEN   3392
#define XCD_BAR_WORDS 3456
#define XB_SPIN_CAP (1u << 18)

__device__ __forceinline__ unsigned xb_ld(unsigned* p)              { return __hip_atomic_load(p, __ATOMIC_RELAXED, __HIP_MEMORY_SCOPE_AGENT); }
__device__ __forceinline__ unsigned xb_add(unsigned* p, unsigned v) { return __hip_atomic_fetch_add(p, v, __ATOMIC_RELAXED, __HIP_MEMORY_SCOPE_AGENT); }
__device__ __forceinline__ unsigned xb_xcc_id() { return (unsigned)__builtin_amdgcn_s_getreg((3 << 11) | 20) & 0xFu; }
#define XB_SPIN(cond, bar) do { unsigned _sp = 0; while (cond) { __builtin_amdgcn_s_sleep(1); \
    if ((++_sp & 255u) == 0u) { if (xb_ld(&(bar)[XB_TMO])) break; if (_sp > XB_SPIN_CAP) { atomicAdd(&(bar)[XB_TMO], 1u); break; } } } } while (0)

struct XcdBarrier {
    unsigned* bar; unsigned x;
    volatile unsigned* st;
};

__device__ __forceinline__ XcdBarrier xcd_barrier_post(unsigned* bar, volatile unsigned* st) {
    XcdBarrier b; b.bar = bar; b.x = xb_xcc_id(); b.st = st;
    if (threadIdx.x == 0) (void)xb_add(&bar[XB_XCNT(b.x)], 1u);
    return b;
}
__device__ __forceinline__ void xcd_barrier_complete(unsigned* bar, unsigned x, unsigned& nloc, unsigned& nx) {
    const unsigned G = gridDim.x * gridDim.y * gridDim.z;
    unsigned sum, cnt, mine, sp = 0u;
    for (;;) {
        sum = 0u; cnt = 0u; mine = 0u;
#pragma unroll
        for (unsigned j = 0; j < 16; ++j) { const unsigned c = xb_ld(&bar[XB_XCNT(j)]); sum += c; cnt += (c > 0u) ? 1u : 0u; mine = (j == x) ? c : mine; }
        if (sum == G) break;
        __builtin_amdgcn_s_sleep(1);
        if ((++sp & 255u) == 0u) { if (xb_ld(&bar[XB_TMO])) break; if (sp > XB_SPIN_CAP) { atomicAdd(&bar[XB_TMO], 1u); break; } }
    }
    nloc = mine > 0u ? mine : 1u; nx = cnt > 0u ? cnt : 1u;
}

__device__ __forceinline__ void xcd_barrier(const XcdBarrier& b) {
    asm volatile("s_waitcnt vmcnt(0)" ::: "memory");
    __syncthreads();
    if (threadIdx.x == 0) {
        unsigned* bar = b.bar;
        __builtin_amdgcn_s_waitcnt(0);
        unsigned nloc = b.st[0], nx = b.st[1];
        if (nloc == 0u) { xcd_barrier_complete(bar, b.x, nloc, nx); b.st[0] = nloc; b.st[1] = nx; }
        const unsigned old = xb_add(&bar[XB_XSUB(b.x)], 1u);
        const unsigned gen = old / nloc;
        if (old + 1u == (gen + 1u) * nloc) {
            __builtin_amdgcn_fence(__ATOMIC_RELEASE, "agent");
            asm volatile("s_waitcnt vmcnt(0)" ::: "memory");
            const unsigned og = xb_add(&bar[XB_TOP], 1u);
            const unsigned tg = og / nx;
            if (og + 1u == (tg + 1u) * nx) xb_add(&bar[XB_TOPGEN], 1u);
            else XB_SPIN(xb_ld(&bar[XB_TOPGEN]) == tg, bar);
            __builtin_amdgcn_fence(__ATOMIC_ACQUIRE, "agent");
            xb_add(&bar[XB_XGEN(b.x)], 1u);
            asm volatile("s_waitcnt vmcnt(0)" ::: "memory");
        } else {
            XB_SPIN(xb_ld(&bar[XB_XGEN(b.x)]) == gen, bar);
            __builtin_amdgcn_fence(__ATOMIC_ACQUIRE, "agent");
            asm volatile("s_waitcnt vmcnt(0)" ::: "memory");
        }
    }
    __syncthreads();
}

constexpr int NPHASE = 14;
template <class Epi> __device__ __forceinline__ void run_gemm(Ctx& C, const bf16* A, const bf16* Bt, int N, int K, const Epi& E) {
    pg8::Gemm g{A, Bt, SEQ, N, K}; pg8::StaticOrder S; S.init(SEQ, N, C.G, C.bid);
    pg8::gemm_phase<Epi, pg8::StaticOrder, false>((PG8_LAS unsigned char*)C.lds, g, S, E, nullptr);
}
__global__ void __launch_bounds__(512, 2) fwd_kernel(Args a) {
    extern __shared__ __attribute__((aligned(16))) unsigned char lds[];
    cg::grid_group grid = cg::this_grid();
    Ctx C{lds, (int)threadIdx.x, (int)(threadIdx.x & 63), __builtin_amdgcn_readfirstlane((int)(threadIdx.x >> 6)), (int)gridDim.x, (int)blockIdx.x, a, a.out, a.ws};
    volatile unsigned* xst = (volatile unsigned*)(lds + LDS_BYTES - 64);
    if (threadIdx.x < 2) xst[threadIdx.x] = 0u;
    __syncthreads();
    XcdBarrier xbar = xcd_barrier_post((unsigned*)(a.ws + WS_BAR), xst);
    const int lo = a.ph_lo, hi = a.ph_hi;
#ifndef PHMASK
#define PHMASK 0xffff
#endif
#define IN(k) (((PHMASK >> (k)) & 1) && lo <= (k) && (k) < hi)
#define SEAM(k) do { if (IN(k) && IN((k) + 1)) { if ((k) == 0) grid.sync(); xcd_barrier(xbar); } } while (0)
    unsigned char* ws = a.ws;
    if (IN(0)) phase0(C);
    SEAM(0);
    if (IN(1)) { pg8::EpiSplit E{(bf16*)(ws + WS_MQK), (bf16*)(ws + WS_MV), (bf16*)(ws + WS_GM), (bf16*)(ws + WS_GA)}; run_gemm(C, (const bf16*)C.out, (const bf16*)(ws + WS_WIN), NPROJ, DM, E); }
    SEAM(1);
    if (IN(2)) phase2(C);
    SEAM(2);
    if (IN(3)) { for (int it = C.bid; it < 512; it += C.G) mlstm_local_item(C, it);
                 for (int it = C.bid; it < 512; it += C.G) moba_select_item(C, it); }
    SEAM(3);
    if (IN(4)) mlstm_scan(C);
    SEAM(4);
    if (IN(5)) { for (int it = C.bid; it < 512; it += C.G) { mlstm_num1_item(C, it); mlstm_out_item(C, it); } }
    SEAM(5);
    if (IN(6)) moba_attn(C);
    SEAM(6);
    if (IN(7)) moba_combine(C);
    SEAM(7);
    if (IN(8)) { pg8::EpiB<1> E1{(bf16*)(ws + WS_MQK), DM, (const bf16*)(ws + WS_GM)}; run_gemm(C, (const bf16*)(ws + WS_MO), (const bf16*)(ws + WS_WBM), DM, 1024, E1);
                 pg8::EpiB<2> E2{(bf16*)(ws + WS_MQK), DM, (const bf16*)(ws + WS_GA)}; run_gemm(C, (const bf16*)(ws + WS_AQ), (const bf16*)(ws + WS_WBA), DM, 1024, E2); }
    SEAM(8);
    if (IN(9)) { pg8::EpiB<0> E{(bf16*)(ws + WS_GM), DM, nullptr}; run_gemm(C, (const bf16*)(ws + WS_MQK), (const bf16*)(ws + WS_WOUT), DM, DM, E); }
    SEAM(9);
    if (IN(10)) rows1(C);
    SEAM(10);
    if (IN(11)) { pg8::EpiB<3> E{(bf16*)(ws + WS_U), DFF, nullptr}; run_gemm(C, (const bf16*)(ws + WS_GA), (const bf16*)(ws + WS_WUP), DFF, DM, E); }
    SEAM(11);
    if (IN(12)) { pg8::EpiB<0> E{(bf16*)(ws + WS_GA), DM, nullptr}; run_gemm(C, (const bf16*)(ws + WS_U), (const bf16*)(ws + WS_WDOWN), DM, DFF, E); }
    SEAM(12);
    if (IN(13)) rows2(C);
#undef IN
#undef SEAM
}

#ifndef MK_SPLIT
#define MK_SPLIT 0
#endif
extern "C" void kernel_launch(void* const* d_in, const int* in_sizes, int n_in, void* d_out, int out_size, void* d_ws, size_t ws_size, hipStream_t stream) {
    static int grid = 0;
    if (grid == 0) {
        if (n_in != 17 || out_size != SEQ * DM || ws_size < WS_NEED) { fprintf(stderr, "kernel_launch: unexpected shapes (n_in %d out %d ws %zu)\n", n_in, out_size, ws_size); grid = -1; return; }
        int dev = 0, cus = 0, per_cu = 0;
        hipGetDevice(&dev); hipDeviceGetAttribute(&cus, hipDeviceAttributeMultiprocessorCount, dev);
        if (hipFuncSetAttribute((const void*)fwd_kernel, hipFuncAttributeMaxDynamicSharedMemorySize, LDS_BYTES) != hipSuccess) { fprintf(stderr, "kernel_launch: hipFuncSetAttribute failed\n"); grid = -1; return; }
        if (hipOccupancyMaxActiveBlocksPerMultiprocessor(&per_cu, (const void*)fwd_kernel, 512, LDS_BYTES) != hipSuccess || per_cu < 1) { fprintf(stderr, "kernel_launch: occupancy query says %d\n", per_cu); per_cu = 1; }
        (void)hipGetLastError();
        grid = cus;
    }
    if (grid < 0) return;
    if (hipMemsetAsync((unsigned char*)d_ws + WS_BAR, 0, 16384, stream) != hipSuccess) { fprintf(stderr, "kernel_launch: memset failed\n"); return; }
    Args a{};
    for (int i = 0; i < 17; ++i) a.in[i] = d_in[i];
    a.out = (float*)d_out; a.ws = (unsigned char*)d_ws;
#if MK_SPLIT
    for (int p = 0; p < NPHASE; ++p) { a.ph_lo = p; a.ph_hi = p + 1; hipLaunchKernelGGL(fwd_kernel, dim3(grid), dim3(512), LDS_BYTES, stream, a); }
#else
    a.ph_lo = 0; a.ph_hi = NPHASE;
    void* args[] = {&a};
    hipError_t e = hipLaunchCooperativeKernel((const void*)fwd_kernel, dim3(grid), dim3(512), args, LDS_BYTES, stream);
    if (e != hipSuccess) fprintf(stderr, "kernel_launch: cooperative launch failed: %s (grid %d)\n", hipGetErrorString(e), grid);
#endif
}
```

```cpp
#include <hip/hip_runtime.h>
#include <hip/hip_cooperative_groups.h>
#include <cstdio>
namespace cg = cooperative_groups;
namespace pg8 {
#define PG8_LAS __attribute__((address_space(3)))
typedef unsigned short bf16_t;
typedef short bf16x8 __attribute__((ext_vector_type(8)));
typedef float f32x4 __attribute__((ext_vector_type(4)));
typedef unsigned u32x4 __attribute__((ext_vector_type(4)));
constexpr int BM = 256, BK = 64, HALF = 128, HTB = HALF * BK * 2  , STAGE_BYTES = 8 * HTB, NXCD = 8, WGM = 8;

__host__ __device__ __forceinline__ int lds_byte(int r, int c) { const int st = (r >> 4) * 2 + (c >> 5), rr = r & 15, cc = c & 31, ob = rr * 64 + cc * 2; return st * 1024 + (ob ^ (((ob >> 9) & 1) << 5)); }
__host__ __device__ __forceinline__ void stage_rc(int b, int& R, int& C) { const int st = b / 1024, sb = b % 1024, swz = sb ^ (((sb >> 9) & 1) << 5); R = (st >> 1) * 16 + swz / 64; C = (st & 1) * 32 + (swz % 64) / 2; }
__host__ __device__ __forceinline__ int perm32(int rho) { const int n = rho >> 4, i = rho & 15; return 8 * (i >> 2) + 4 * n + (i & 3); }

struct Unit { int pm, pn; };
struct Gemm { const bf16_t* A; const bf16_t* Bt; int M, N, K; };

struct StaticOrder {
    int nM, nN, nwg, G, c;
    __host__ __device__ void init(int M, int N, int G_, int c_) { nM = M / BM; nN = N / BM; nwg = nM * nN; G = G_; c = c_; }
    __host__ __device__ bool next(int i, Unit& u) const {
        const long L = (long)i * G + c; if (L >= nwg) return false;
        int wgid = (int)L; { const int q = nwg / NXCD, r = nwg % NXCD, xcd = wgid % NXCD, off = wgid / NXCD; wgid = (xcd < r ? xcd * (q + 1) : r * (q + 1) + (xcd - r) * q) + off; }
        const int nig = WGM * nN, gid = wgid / nig, fm = gid * WGM, gsz = (nM - fm) < WGM ? (nM - fm) : WGM;
        u.pm = fm + ((wgid % nig) % gsz); u.pn = (wgid % nig) / gsz; return true;
    }
    __device__ __forceinline__ void a_ready(const Unit&) const {}
    __device__ __forceinline__ void done(const Unit&) const {}
};
__device__ __forceinline__ unsigned cvt_pk_bf16(float lo, float hi) { unsigned r; asm volatile("v_cvt_pk_bf16_f32 %0, %1, %2" : "=v"(r) : "v"(lo), "v"(hi)); return r; }
typedef float f32x2 __attribute__((ext_vector_type(2)));
__device__ __forceinline__ float sigm(float x) { return __builtin_amdgcn_rcpf(1.0f + __expf(-x)); }
__device__ __forceinline__ float bflo(unsigned w) { return __uint_as_float(w << 16); }
__device__ __forceinline__ float bfhi(unsigned w) { return __uint_as_float(w & 0xffff0000u); }
template <int MODE> struct EpiB {
    static constexpr bool PERM = true, AFTER_DRAIN = false;
    bf16_t* O; int ldc; const bf16_t* aux;
    __device__ __forceinline__ void operator()(const f32x4 (&acc)[2][2][4][2], const Unit& u, int wr, int wc, int fr, int fq) const {
        const int row0 = u.pm * BM + wr * 64 + fr, col0 = u.pn * BM + wc * 32 + 8 * fq;
#pragma unroll
        for (int ai = 0; ai < 2; ++ai)
#pragma unroll
            for (int m = 0; m < 4; ++m) { const size_t off = (size_t)(row0 + ai * HALF + m * 16) * ldc + col0;
#pragma unroll
                for (int bj = 0; bj < 2; ++bj) { f32x4 v0 = acc[ai][bj][m][0], v1 = acc[ai][bj][m][1]; const size_t o = off + bj * HALF;
                    if (MODE == 1 || MODE == 2) { const u32x4 g = *(const u32x4*)(aux + o);
                        v0[0] *= sigm(bflo(g.x)); v0[1] *= sigm(bfhi(g.x)); v0[2] *= sigm(bflo(g.y)); v0[3] *= sigm(bfhi(g.y));
                        v1[0] *= sigm(bflo(g.z)); v1[1] *= sigm(bfhi(g.z)); v1[2] *= sigm(bflo(g.w)); v1[3] *= sigm(bfhi(g.w)); }
                    if (MODE == 2) { const u32x4 p = *(const u32x4*)(O + o);
                        v0[0] += bflo(p.x); v0[1] += bfhi(p.x); v0[2] += bflo(p.y); v0[3] += bfhi(p.y);
                        v1[0] += bflo(p.z); v1[1] += bfhi(p.z); v1[2] += bflo(p.w); v1[3] += bfhi(p.w); }
                    if (MODE == 3) {
#pragma unroll
                        for (int j = 0; j < 4; ++j) { const float a = fmaxf(v0[j], 0.f), b = fmaxf(v1[j], 0.f); v0[j] = a * a; v1[j] = b * b; } }
                    u32x4 w; w.x = cvt_pk_bf16(v0[0], v0[1]); w.y = cvt_pk_bf16(v0[2], v0[3]); w.z = cvt_pk_bf16(v1[0], v1[1]); w.w = cvt_pk_bf16(v1[2], v1[3]);
                    *(u32x4*)(O + o) = w; } }
    }
};
struct EpiSplit {
    static constexpr bool PERM = true, AFTER_DRAIN = false;
    bf16_t* MQK; bf16_t* MV; bf16_t* GM; bf16_t* GA;
    __device__ __forceinline__ void operator()(const f32x4 (&acc)[2][2][4][2], const Unit& u, int wr, int wc, int fr, int fq) const {
        bf16_t* base; int ldc, colt; const int pn = u.pn;
        if (pn < 8) { base = MQK; ldc = 2048; colt = pn * 256; }
        else if (pn < 28) { const int t = (pn - 8) >> 2; base = MV + (size_t)t * ((size_t)16384 * 1024); ldc = 1024; colt = ((pn - 8) & 3) * 256; }
        else if (pn < 36) { base = GM; ldc = 2048; colt = (pn - 28) * 256; }
        else { base = GA; ldc = 2048; colt = (pn - 36) * 256; }
        const int row0 = u.pm * BM + wr * 64 + fr, col0 = colt + wc * 32 + 8 * fq;
#pragma unroll
        for (int ai = 0; ai < 2; ++ai)
#pragma unroll
            for (int m = 0; m < 4; ++m) { bf16_t* rowp = base + (size_t)(row0 + ai * HALF + m * 16) * ldc + col0;
#pragma unroll
                for (int bj = 0; bj < 2; ++bj) { const f32x4 v0 = acc[ai][bj][m][0], v1 = acc[ai][bj][m][1];
                    u32x4 w; w.x = cvt_pk_bf16(v0[0], v0[1]); w.y = cvt_pk_bf16(v0[2], v0[3]); w.z = cvt_pk_bf16(v1[0], v1[1]); w.w = cvt_pk_bf16(v1[2], v1[3]);
                    *(u32x4*)(rowp + bj * HALF) = w; } }
    }
};

template <class Epi, class Sched, bool STAMP = false>
__device__ __forceinline__ void gemm_phase(PG8_LAS unsigned char* lds, const Gemm g, const Sched& S, const Epi& E, unsigned long long* stamps) {
    const int tid = threadIdx.x, wid = __builtin_amdgcn_readfirstlane(tid >> 6), lane = tid & 63, wr = wid >> 2, wc = wid & 3, fr = lane & 15, fq = lane >> 4;
    const int K = g.K, nt = K / BK;
    int ts_lo = 0, ts_hi = 0, nts = 0; const unsigned long long rt_entry = STAMP ? (unsigned long long)wall_clock64() : 0ull;
#define PG8_STAMP() do { if (STAMP && wid == 0 && nts < 64) { const unsigned long long _c = (unsigned long long)clock64(); \
        ts_lo = (lane == nts) ? (int)(unsigned)_c : ts_lo; ts_hi = (lane == nts) ? (int)(unsigned)(_c >> 32) : ts_hi; ++nts; } } while (0)
    PG8_STAMP();
    unsigned voffA[2], voffB[2];
#pragma unroll
    for (int i = 0; i < 2; ++i) { int R, C; stage_rc(tid * 16 + i * 8192, R, C); const int Rb = Epi::PERM ? ((R & ~31) + perm32(R & 31)) : R;
        voffA[i] = (unsigned)(R * K + C) * 2u; voffB[i] = (unsigned)(Rb * K + C) * 2u; }
    const size_t kstep = (size_t)(BK * 2);
    const size_t hstep = (size_t)HALF * K * 2;
    const size_t tstep = 2 * hstep;
    const unsigned ldsw = (unsigned)wid * 1024u;
    const int aoff = lds_byte(wr * 64 + fr, fq * 8), boff = lds_byte(wc * 32 + fr, fq * 8);
#define PG8_SA(b, h) (((b) * 2 + (h)) * HTB)
#define PG8_SB(b, h) ((4 + (b) * 2 + (h)) * HTB)
#define PG8_STAGE(bufoff, gbase, voff) do { _Pragma("unroll") for (int _i = 0; _i < 2; ++_i) \
        __builtin_amdgcn_global_load_lds((const unsigned*)((const char*)(gbase) + (voff)[_i]), (PG8_LAS unsigned*)(lds + (bufoff) + ldsw + _i * 8192), 16, 0, 0); } while (0)
#define PG8_LDA(dst, b, h) do { _Pragma("unroll") for (int m = 0; m < 4; ++m) _Pragma("unroll") for (int k = 0; k < 2; ++k) dst[m][k] = *(const PG8_LAS bf16x8*)(lds + PG8_SA(b, h) + aoff + m * 2048 + k * 1024); } while (0)
#define PG8_LDB(dst, b, h) do { _Pragma("unroll") for (int n = 0; n < 2; ++n) _Pragma("unroll") for (int k = 0; k < 2; ++k) dst[n][k] = *(const PG8_LAS bf16x8*)(lds + PG8_SB(b, h) + boff + n * 2048 + k * 1024); } while (0)
#define PG8_MMA(ai, bj, At, Bt) do { __builtin_amdgcn_s_setprio(1); _Pragma("unroll") for (int m = 0; m < 4; ++m) _Pragma("unroll") for (int n = 0; n < 2; ++n) _Pragma("unroll") for (int k = 0; k < 2; ++k) \
        acc[ai][bj][m][n] = __builtin_amdgcn_mfma_f32_16x16x32_bf16(Bt[n][k], At[m][k], acc[ai][bj][m][n], 0, 0, 0); __builtin_amdgcn_s_setprio(0); } while (0)
#define PG8_WAIT_V(n) asm volatile("s_waitcnt vmcnt(" #n ")" ::: "memory")
#define PG8_WAIT_L(n) asm volatile("s_waitcnt lgkmcnt(" #n ")" ::: "memory")
#define PG8_BAR __builtin_amdgcn_s_barrier()
#define PG8_SCHED __builtin_amdgcn_sched_barrier(0)
    Unit cur, nxt; int ui = 0;
    if (!S.next(0, cur)) return;
    f32x4 acc[2][2][4][2];
#pragma unroll
    for (int a = 0; a < 2; ++a)
#pragma unroll
        for (int b = 0; b < 2; ++b)
#pragma unroll
            for (int m = 0; m < 4; ++m)
#pragma unroll
                for (int n = 0; n < 2; ++n) acc[a][b][m][n] = (f32x4){0.f, 0.f, 0.f, 0.f};
    bf16x8 At[4][2], B0[2][2], B1[2][2];
    const char* cA = (const char*)g.A + (size_t)cur.pm * tstep; const char* cB = (const char*)g.Bt + (size_t)cur.pn * tstep;
    S.a_ready(cur);
    PG8_STAGE(PG8_SB(0, 0), cB, voffB); PG8_STAGE(PG8_SA(0, 0), cA, voffA); PG8_STAGE(PG8_SB(0, 1), cB + hstep, voffB); PG8_STAGE(PG8_SA(0, 1), cA + hstep, voffA);
    if (wr == 1) PG8_BAR;
    PG8_WAIT_V(4); PG8_BAR;
    PG8_STAGE(PG8_SB(1, 0), cB + kstep, voffB); PG8_STAGE(PG8_SA(1, 0), cA + kstep, voffA); PG8_STAGE(PG8_SB(1, 1), cB + hstep + kstep, voffB);
    PG8_WAIT_V(6); PG8_BAR;
    PG8_STAMP();
    for (;;) {
        const bool has_next = S.next(ui + 1, nxt);
        const char* nA = has_next ? (const char*)g.A + (size_t)nxt.pm * tstep : cA; const char* nB = has_next ? (const char*)g.Bt + (size_t)nxt.pn * tstep : cB;
        for (int t = 0; t < nt; t += 2) {
            const bool last = (t == nt - 2);
            const char* a1 = cA + (size_t)(t + 1) * kstep;
            const char* a2 = last ? nA : cA + (size_t)(t + 2) * kstep; const char* b2 = last ? nB : cB + (size_t)(t + 2) * kstep;
            const char* a3 = a2 + kstep; const char* b3 = b2 + kstep;
            if (last && has_next) S.a_ready(nxt);
            PG8_LDB(B0, 0, 0); PG8_SCHED; PG8_LDA(At, 0, 0); PG8_STAGE(PG8_SA(1, 1), a1 + hstep, voffA);
            PG8_WAIT_L(8); PG8_BAR; PG8_WAIT_L(0); PG8_MMA(0, 0, At, B0); PG8_BAR; PG8_SCHED;
            PG8_LDB(B1, 0, 1); PG8_STAGE(PG8_SB(0, 0), b2, voffB);
            PG8_BAR; PG8_WAIT_L(0); PG8_MMA(0, 1, At, B1); PG8_BAR;
            PG8_LDA(At, 0, 1); PG8_STAGE(PG8_SA(0, 0), a2, voffA);
            PG8_BAR; PG8_WAIT_L(0); PG8_MMA(1, 0, At, B0); PG8_BAR; PG8_SCHED;
            PG8_STAGE(PG8_SB(0, 1), b2 + hstep, voffB);
            PG8_WAIT_V(6); PG8_BAR; PG8_MMA(1, 1, At, B1); PG8_BAR;
            PG8_LDB(B0, 1, 0); PG8_SCHED; PG8_LDA(At, 1, 0); PG8_STAGE(PG8_SA(0, 1), a2 + hstep, voffA);
            PG8_WAIT_L(8); PG8_BAR; PG8_WAIT_L(0); PG8_MMA(0, 0, At, B0); PG8_BAR; PG8_SCHED;
            PG8_LDB(B1, 1, 1); PG8_STAGE(PG8_SB(1, 0), b3, voffB);
            PG8_BAR; PG8_WAIT_L(0); PG8_MMA(0, 1, At, B1); PG8_BAR;
            PG8_LDA(At, 1, 1); PG8_STAGE(PG8_SA(1, 0), a3, voffA);
            PG8_BAR; PG8_WAIT_L(0); PG8_MMA(1, 0, At, B0); PG8_BAR; PG8_SCHED;
            PG8_STAGE(PG8_SB(1, 1), b3 + hstep, voffB);
            PG8_WAIT_V(6); PG8_BAR; PG8_MMA(1, 1, At, B1); PG8_BAR;
        }
        PG8_STAMP();
        if constexpr (!Epi::AFTER_DRAIN) { E(acc, cur, wr, wc, fr, fq); S.done(cur); }
        PG8_STAMP();
        if (!has_next) break;
#pragma unroll
        for (int a = 0; a < 2; ++a)
#pragma unroll
            for (int b = 0; b < 2; ++b)
#pragma unroll
                for (int m = 0; m < 4; ++m)
#pragma unroll
                    for (int n = 0; n < 2; ++n) acc[a][b][m][n] = (f32x4){0.f, 0.f, 0.f, 0.f};
        cur = nxt; cA = nA; cB = nB; ++ui;
    }
    PG8_WAIT_V(0);
    if (wr == 0) PG8_BAR;
    PG8_BAR;
    if constexpr (Epi::AFTER_DRAIN) { E.fused(acc, cur, wr, wc, fr, fq, lds, wid, lane); S.done(cur); }
    PG8_STAMP();
    if (STAMP && wid == 0) { stamps[lane] = lane < nts ? (((unsigned long long)(unsigned)ts_hi << 32) | (unsigned)ts_lo) : 0ull;
        if (lane == 62) stamps[62] = rt_entry; if (lane == 63) stamps[63] = (unsigned long long)wall_clock64(); }
#undef PG8_STAMP
#undef PG8_SA
#undef PG8_SB
#undef PG8_STAGE
#undef PG8_LDA
#undef PG8_LDB
#undef PG8_MMA
#undef PG8_WAIT_V
#undef PG8_WAIT_L
#undef PG8_BAR
#undef PG8_SCHED
}
}

typedef unsigned short bf16;
typedef short bf16x8 __attribute__((ext_vector_type(8)));
typedef float f32x4 __attribute__((ext_vector_type(4)));
constexpr int SEQ = 16384, DM = 2048, INC = 11272, NPROJ = 11264, DFF = 8192;
constexpr float EPS = 1e-6f;
constexpr size_t MiB = (size_t)1 << 20;
constexpr size_t WS_IFP = 0;
constexpr size_t WS_KMEAN = 512 * 1024;
constexpr size_t WS_CNT = 768 * 1024;
constexpr size_t WS_FCH = 4 * MiB;
constexpr size_t WS_MLOC = 4 * MiB + 64 * 1024;
constexpr size_t WS_MPREV = 904 * 1024;
constexpr size_t WS_BAR = 960 * 1024;
constexpr size_t WS_NST = 1 * MiB;
constexpr size_t WS_NPREV = 1536 * 1024;
constexpr size_t WS_LSE = 2 * MiB;
constexpr size_t WS_WUP = 8 * MiB, WS_WDOWN = 40 * MiB, WS_WIN = 72 * MiB, WS_WBM = 116 * MiB, WS_WBA = 120 * MiB, WS_WOUT = 124 * MiB;
constexpr size_t WS_MQK = 132 * MiB;
constexpr size_t WS_MV = 196 * MiB, WS_MO = 228 * MiB, WS_AQ = 260 * MiB, WS_AK = 292 * MiB, WS_AV = 324 * MiB;
constexpr size_t WS_GM = 356 * MiB;
constexpr size_t WS_GA = 420 * MiB;
constexpr size_t WS_LIST = 484 * MiB;
constexpr size_t WS_U = 132 * MiB;
constexpr size_t WS_NEED = 500 * MiB;
constexpr int LDS_BYTES = 159744;

__device__ __forceinline__ float bf2f(unsigned short b) { return __uint_as_float(((unsigned)b) << 16); }
__device__ __forceinline__ unsigned short f2bf(float f) { unsigned u = __float_as_uint(f); u += 0x7fffu + ((u >> 16) & 1u); return (unsigned short)(u >> 16); }
__device__ __forceinline__ unsigned pk2(float lo, float hi) { return (unsigned)f2bf(lo) | ((unsigned)f2bf(hi) << 16); }
__device__ __forceinline__ float lo16(unsigned w) { return __uint_as_float(w << 16); }
__device__ __forceinline__ float hi16(unsigned w) { return __uint_as_float(w & 0xffff0000u); }
__device__ __forceinline__ float sigmoidf_(float x) { return __builtin_amdgcn_rcpf(1.0f + __expf(-x)); }
__device__ __forceinline__ float logsigf_(float x) { return fminf(x, 0.f) - log1pf(expf(-fabsf(x))); }
__device__ __forceinline__ float wave_sum(float v) {
#pragma unroll
    for (int o = 1; o < 64; o <<= 1) v += __shfl_xor(v, o);
    return v; }
__device__ __forceinline__ float wave_max(float v) {
#pragma unroll
    for (int o = 1; o < 64; o <<= 1) v = fmaxf(v, __shfl_xor(v, o));
    return v; }
__device__ __forceinline__ float wave_incl_sum(float v, int lane) {
#pragma unroll
    for (int o = 1; o < 64; o <<= 1) { const float t = __shfl_up(v, o); if (lane >= o) v += t; }
    return v; }
__device__ __forceinline__ float wave_incl_max(float v, int lane) {
#pragma unroll
    for (int o = 1; o < 64; o <<= 1) { const float t = __shfl_up(v, o); if (lane >= o) v = fmaxf(v, t); }
    return v; }
__device__ __forceinline__ int wave_incl_sum_i(int v, int lane) {
#pragma unroll
    for (int o = 1; o < 64; o <<= 1) { const int t = __shfl_up(v, o); if (lane >= o) v += t; }
    return v; }
__device__ __forceinline__ f32x4 mma16(bf16x8 a, bf16x8 b, f32x4 c) { return __builtin_amdgcn_mfma_f32_16x16x32_bf16(a, b, c, 0, 0, 0); }
__device__ __forceinline__ void unpack8(const uint4 v, float (&f)[8]) { f[0] = lo16(v.x); f[1] = hi16(v.x); f[2] = lo16(v.y); f[3] = hi16(v.y); f[4] = lo16(v.z); f[5] = hi16(v.z); f[6] = lo16(v.w); f[7] = hi16(v.w); }
__device__ __forceinline__ uint4 pack8(const float (&f)[8]) { uint4 v; v.x = pk2(f[0], f[1]); v.y = pk2(f[2], f[3]); v.z = pk2(f[4], f[5]); v.w = pk2(f[6], f[7]); return v; }

struct Args { const void* in[17]; float* out; unsigned char* ws; int ph_lo, ph_hi; };
struct Ctx {
    unsigned char* lds; int tid, lane, wave, G, bid;
    const Args& a;
    float* out; unsigned char* ws;
};

__device__ __forceinline__ void p0_transpose_item(const float* W, int K, int ldw, int nblk, bool gap, bf16* WT, float* scr, int item, int lane) {
    const int kb = item / nblk, nb = item % nblk, k0 = 64 * kb, n0 = 32 * nb, n0s = n0 + ((gap && n0 >= 4096) ? 8 : 0);
    float wv[32];
#pragma unroll
    for (int i = 0; i < 32; ++i) wv[i] = W[(size_t)(k0 + 2 * i + (lane >> 5)) * ldw + n0s + (lane & 31)];
#pragma unroll
    for (int i = 0; i < 32; ++i) scr[(2 * i + (lane >> 5)) * 33 + (lane & 31)] = wv[i];
    __builtin_amdgcn_s_waitcnt(0xc07f); asm volatile("" ::: "memory");
    const int c = lane & 7;
#pragma unroll
    for (int j = 0; j < 4; ++j) { const int n = (lane >> 3) + 8 * j; const float* s = scr + (8 * c) * 33 + n;
        uint4 o; o.x = pk2(s[0 * 33], s[1 * 33]); o.y = pk2(s[2 * 33], s[3 * 33]); o.z = pk2(s[4 * 33], s[5 * 33]); o.w = pk2(s[6 * 33], s[7 * 33]);
        *(uint4*)(WT + (size_t)(n0 + n) * K + k0 + 8 * c) = o; }
    __builtin_amdgcn_s_waitcnt(0xc07f); asm volatile("" ::: "memory");
}
__device__ __forceinline__ void wg_transpose_item(const float* W, int K, int ldw, int nblk, bool gap, bf16* WT, float* tile, int item, int tid) {
    const int kb = item / nblk, nb = item % nblk, k0 = 64 * kb, n0 = 256 * nb, n0s = n0 + ((gap && n0 >= 4096) ? 8 : 0);
    float4 v[8];
#pragma unroll
    for (int i = 0; i < 8; ++i) { const int idx = tid + i * 512, row = idx >> 6, c4 = idx & 63; v[i] = *(const float4*)(W + (size_t)(k0 + row) * ldw + n0s + 4 * c4); }
    __syncthreads();
#pragma unroll
    for (int i = 0; i < 8; ++i) { const int idx = tid + i * 512, row = idx >> 6, c4 = idx & 63; float* t = tile + row * 257 + 4 * c4; t[0] = v[i].x; t[1] = v[i].y; t[2] = v[i].z; t[3] = v[i].w; }
    __syncthreads();
    const int c = tid & 7;
#pragma unroll
    for (int p = 0; p < 4; ++p) { const int n = p * 64 + (tid >> 3); const float* s = tile + (8 * c) * 257 + n;
        uint4 o; o.x = pk2(s[0 * 257], s[1 * 257]); o.y = pk2(s[2 * 257], s[3 * 257]); o.z = pk2(s[4 * 257], s[5 * 257]); o.w = pk2(s[6 * 257], s[7 * 257]);
        *(uint4*)(WT + (size_t)(n0 + n) * K + k0 + 8 * c) = o; }
}
__device__ __forceinline__ int wif_off(int k) { return k * 8 + (k >> 2) * 4; }
__device__ __forceinline__ void phase0(Ctx& C) {
    float* WIF = (float*)C.lds;
    for (int idx = C.tid; idx < 2048 * 8; idx += 512) { const int k = idx >> 3, j = idx & 7; WIF[wif_off(k) + j] = ((const float*)C.a.in[3])[(size_t)k * INC + 4096 + j]; }
    __syncthreads();
    const int gw = C.bid * 8 + C.wave, NGW = C.G * 8, lane = C.lane;
    bf16* XN = (bf16*)C.out; float* IFP = (float*)(C.ws + WS_IFP);
    for (int row = gw; row < SEQ; row += NGW) {
        const float4* xr = (const float4*)(((const float*)C.a.in[0]) + (size_t)row * DM) + lane; float ss = 0.f; float4 v[8], nw[8];
#pragma unroll
        for (int j = 0; j < 8; ++j) { v[j] = xr[64 * j]; nw[j] = *(const float4*)(((const float*)C.a.in[2]) + 256 * j + 4 * lane); }
#pragma unroll
        for (int j = 0; j < 8; ++j) ss += (v[j].x * v[j].x + v[j].y * v[j].y) + (v[j].z * v[j].z + v[j].w * v[j].w);
        const float rstd = rsqrtf(wave_sum(ss) * (1.f / DM) + EPS);
        float a8[8];
#pragma unroll
        for (int i = 0; i < 8; ++i) a8[i] = 0.f;
#pragma unroll
        for (int j = 0; j < 8; ++j) { const int k = 256 * j + 4 * lane;
            float xn[4] = {v[j].x * rstd * nw[j].x, v[j].y * rstd * nw[j].y, v[j].z * rstd * nw[j].z, v[j].w * rstd * nw[j].w};
            uint2 o; o.x = pk2(xn[0], xn[1]); o.y = pk2(xn[2], xn[3]); *(uint2*)(XN + (size_t)row * DM + k) = o;
#pragma unroll
            for (int e = 0; e < 4; ++e) { const float4* wf = (const float4*)(WIF + wif_off(k + e)); const float4 w0 = wf[0], w1 = wf[1];
                a8[0] += xn[e] * w0.x; a8[1] += xn[e] * w0.y; a8[2] += xn[e] * w0.z; a8[3] += xn[e] * w0.w; a8[4] += xn[e] * w1.x; a8[5] += xn[e] * w1.y; a8[6] += xn[e] * w1.z; a8[7] += xn[e] * w1.w; }
            asm volatile("" ::: "memory"); }
#pragma unroll
        for (int i = 0; i < 8; ++i) a8[i] = wave_sum(a8[i]);
        if (lane == 0) { float4* o = (float4*)(IFP + (size_t)row * 8); o[0] = make_float4(a8[0], a8[1], a8[2], a8[3]); o[1] = make_float4(a8[4], a8[5], a8[6], a8[7]); }
    }
    __syncthreads();
    float* tile = (float*)C.lds;
    constexpr int J_IN = 32 * 44, J_BM = 16 * 8, J_OUT = 32 * 8, NJT = J_IN + 2 * J_BM + J_OUT;
    for (int it = C.bid; it < NJT; it += C.G) { int r = it;
        if (r < J_IN) { wg_transpose_item(((const float*)C.a.in[3]), DM, INC, 44, true, (bf16*)(C.ws + WS_WIN), tile, r, C.tid); continue; } r -= J_IN;
        if (r < J_BM) { wg_transpose_item(((const float*)C.a.in[9]), 1024, DM, 8, false, (bf16*)(C.ws + WS_WBM), tile, r, C.tid); continue; } r -= J_BM;
        if (r < J_BM) { wg_transpose_item(((const float*)C.a.in[10]), 1024, DM, 8, false, (bf16*)(C.ws + WS_WBA), tile, r, C.tid); continue; } r -= J_BM;
        wg_transpose_item(((const float*)C.a.in[11]), DM, DM, 8, false, (bf16*)(C.ws + WS_WOUT), tile, r, C.tid); }
    __syncthreads();
}

__device__ __forceinline__ void convert_ffn_weights(Ctx& C, int first_wg) {
    if (C.bid < first_wg) return;
    float* tile = (float*)C.lds;
    constexpr int J_UP = 32 * 32, J_DOWN = 128 * 8;
    for (int it = C.bid - first_wg; it < J_UP + J_DOWN; it += C.G - first_wg) {
        if (it < J_UP) wg_transpose_item(((const float*)C.a.in[14]), DM, DFF, 32, false, (bf16*)(C.ws + WS_WUP), tile, it, C.tid);
        else wg_transpose_item(((const float*)C.a.in[15]), DFF, DM, 8, false, (bf16*)(C.ws + WS_WDOWN), tile, it - J_UP, C.tid); }
}
__device__ __forceinline__ void phase2(Ctx& C) {
    const bf16* MQK = (const bf16*)(C.ws + WS_MQK); bf16* QKC = (bf16*)C.out;
    const int tid = C.tid;
    for (int item = C.bid; item < SEQ / 64; item += C.G) {
        const int half = tid >> 8, cg8 = (tid & 255) * 8, t0 = item * 64 + half * 32;
        float w[4][8], b[8];
#pragma unroll
        for (int j = 0; j < 4; ++j) { const float4 a = *(const float4*)(((const float*)C.a.in[4]) + j * 2048 + cg8), bb = *(const float4*)(((const float*)C.a.in[4]) + j * 2048 + cg8 + 4);
            w[j][0] = a.x; w[j][1] = a.y; w[j][2] = a.z; w[j][3] = a.w; w[j][4] = bb.x; w[j][5] = bb.y; w[j][6] = bb.z; w[j][7] = bb.w; }
        { const float4 a = *(const float4*)(((const float*)C.a.in[5]) + cg8), bb = *(const float4*)(((const float*)C.a.in[5]) + cg8 + 4); b[0] = a.x; b[1] = a.y; b[2] = a.z; b[3] = a.w; b[4] = bb.x; b[5] = bb.y; b[6] = bb.z; b[7] = bb.w; }
        float r0[8], r1[8], r2[8], cur[8];
#pragma unroll
        for (int i = 0; i < 8; ++i) { r0[i] = 0.f; r1[i] = 0.f; r2[i] = 0.f; }
        if (t0 >= 3) { unpack8(*(const uint4*)(MQK + (size_t)(t0 - 3) * 2048 + cg8), r0); unpack8(*(const uint4*)(MQK + (size_t)(t0 - 2) * 2048 + cg8), r1); unpack8(*(const uint4*)(MQK + (size_t)(t0 - 1) * 2048 + cg8), r2); }
        const float sc = (cg8 >= 1024) ? 0.0625f : 1.0f;
#pragma unroll 4
        for (int t = t0; t < t0 + 32; ++t) {
            unpack8(*(const uint4*)(MQK + (size_t)t * 2048 + cg8), cur);
            float o[8];
#pragma unroll
            for (int i = 0; i < 8; ++i) { const float y = b[i] + w[0][i] * r0[i] + w[1][i] * r1[i] + w[2][i] * r2[i] + w[3][i] * cur[i]; o[i] = y * sigmoidf_(y) * sc; r0[i] = r1[i]; r1[i] = r2[i]; r2[i] = cur[i]; }
            *(uint4*)(QKC + (size_t)t * 2048 + cg8) = pack8(o);
        }
    }
    bf16* AQ = (bf16*)(C.ws + WS_AQ); bf16* AK = (bf16*)(C.ws + WS_AK); float* KMEAN = (float*)(C.ws + WS_KMEAN);
    float* red = (float*)C.lds;
    const int tp = tid >> 3, dg = tid & 7;
    float invf[8];
#pragma unroll
    for (int i = 0; i < 8; ++i) invf[i] = 1.0f / powf(10000.0f, (float)(2 * (dg * 8 + i)) / 128.0f);
    for (int item = C.bid; item < 512; item += C.G) {
        const int h = item >> 6, n = item & 63;
        float ks1[8], ks2[8];
#pragma unroll
        for (int i = 0; i < 8; ++i) { ks1[i] = 0.f; ks2[i] = 0.f; }
        for (int pass = 0; pass < 4; ++pass) {
            const int t = n * 256 + pass * 64 + tp; const float p = (float)((const int*)C.a.in[1])[t];
            float cs[8], sn[8];
#pragma unroll
            for (int i = 0; i < 8; ++i) { const float ang = p * invf[i]; const double rev = (double)ang * 0.15915494309189535; const float fr = (float)(rev - rint(rev)); sn[i] = __builtin_amdgcn_sinf(fr); cs[i] = __builtin_amdgcn_cosf(fr); }
            const size_t o1 = (size_t)t * 1024 + h * 128 + dg * 8, o2 = o1 + 64;
            float x1[8], x2[8], y1[8], y2[8];
            unpack8(*(const uint4*)(AQ + o1), x1); unpack8(*(const uint4*)(AQ + o2), x2);
#pragma unroll
            for (int i = 0; i < 8; ++i) { y1[i] = x1[i] * cs[i] - x2[i] * sn[i]; y2[i] = x2[i] * cs[i] + x1[i] * sn[i]; }
            *(uint4*)(AQ + o1) = pack8(y1); *(uint4*)(AQ + o2) = pack8(y2);
            unpack8(*(const uint4*)(AK + o1), x1); unpack8(*(const uint4*)(AK + o2), x2);
#pragma unroll
            for (int i = 0; i < 8; ++i) { y1[i] = x1[i] * cs[i] - x2[i] * sn[i]; y2[i] = x2[i] * cs[i] + x1[i] * sn[i]; ks1[i] += y1[i]; ks2[i] += y2[i]; }
            *(uint4*)(AK + o1) = pack8(y1); *(uint4*)(AK + o2) = pack8(y2);
        }
        __syncthreads();
#pragma unroll
        for (int i = 0; i < 8; ++i) { red[tp * 128 + dg * 8 + i] = ks1[i]; red[tp * 128 + 64 + dg * 8 + i] = ks2[i]; }
        __syncthreads();
        if (tid < 128) { float s = 0.f; for (int r = 0; r < 64; ++r) s += red[r * 128 + tid]; KMEAN[(size_t)item * 128 + tid] = s * (1.0f / 256.0f); }
    }
    __syncthreads();
}

__device__ __forceinline__ void gate_scalars(const Ctx& C, int c, int h, int lane, float& b0, float& b1, float& li0, float& li1) {
    const float* IFP = (const float*)(C.ws + WS_IFP);
    const float fb = ((const float*)C.a.in[7])[h], ib = ((const float*)C.a.in[6])[h];
    const float f0 = IFP[(size_t)(c * 128 + lane) * 8 + 4 + h] + fb, f1 = IFP[(size_t)(c * 128 + 64 + lane) * 8 + 4 + h] + fb;
    li0 = IFP[(size_t)(c * 128 + lane) * 8 + h] + ib; li1 = IFP[(size_t)(c * 128 + 64 + lane) * 8 + h] + ib;
    b0 = wave_incl_sum(logsigf_(f0), lane); const float tot0 = __shfl(b0, 63); b1 = wave_incl_sum(logsigf_(f1), lane) + tot0;
}
__device__ __forceinline__ void load_transposed_256(const bf16* src, int ld, bf16* Tt, const float* ev, int tid) {
    const int l = tid & 127, cgp = tid >> 7; const float el = ev ? ev[l] : 1.0f;
    const bf16* row = src + (size_t)l * ld;
#pragma unroll
    for (int i = 0; i < 8; ++i) { const int g = cgp * 8 + i; float f[8]; unpack8(*(const uint4*)(row + g * 8), f);
#pragma unroll
        for (int j = 0; j < 8; ++j) Tt[(g * 8 + j) * 136 + l] = f2bf(f[j] * el); }
}
__device__ __forceinline__ void mlstm_local_item(Ctx& C, int item) {
    const int c = item >> 2, h = item & 3, tid = C.tid, lane = C.lane, wave = C.wave, g = lane >> 4, tq = lane & 15;
    bf16* Vt = (bf16*)C.lds; bf16* Kt = Vt + 256 * 136; float* ev = (float*)(C.lds + 139264);
    const bf16* QKC = (const bf16*)C.out; bf16* CST = (bf16*)((unsigned char*)C.out + 64 * MiB); const bf16* MV = (const bf16*)(C.ws + WS_MV);
    if (wave == 0) {
        float b0, b1, li0, li1; gate_scalars(C, c, h, lane, b0, b1, li0, li1);
        const float F = __shfl(b1, 63); const float w0 = F - b0 + li0, w1 = F - b1 + li1; const float ml = wave_max(fmaxf(w0, w1));
        ev[lane] = expf(w0 - ml); ev[lane + 64] = expf(w1 - ml);
        if (lane == 0) { ((float*)(C.ws + WS_FCH))[item * 32] = F; ((float*)(C.ws + WS_MLOC))[item * 32] = ml; }
    }
    __syncthreads();
    load_transposed_256(MV + (size_t)(c * 128) * 1024 + h * 256, 1024, Vt, ev, tid);
    load_transposed_256(QKC + (size_t)(c * 128) * 2048 + 1024 + h * 256, 2048, Kt, nullptr, tid);
    __syncthreads();
#pragma unroll 1
    for (int nh = 0; nh < 2; ++nh) {
        f32x4 acc[2][8];
#pragma unroll
        for (int mi = 0; mi < 2; ++mi)
#pragma unroll
            for (int ni = 0; ni < 8; ++ni) acc[mi][ni] = (f32x4){0.f, 0.f, 0.f, 0.f};
#pragma unroll
        for (int ks = 0; ks < 4; ++ks) {
            bf16x8 a[2];
#pragma unroll
            for (int mi = 0; mi < 2; ++mi) a[mi] = *(const bf16x8*)(Kt + (32 * wave + mi * 16 + tq) * 136 + ks * 32 + 8 * g);
#pragma unroll
            for (int ni = 0; ni < 8; ++ni) { const bf16x8 b = *(const bf16x8*)(Vt + ((nh * 8 + ni) * 16 + tq) * 136 + ks * 32 + 8 * g);
#pragma unroll
                for (int mi = 0; mi < 2; ++mi) acc[mi][ni] = mma16(a[mi], b, acc[mi][ni]); }
        }
#pragma unroll
        for (int mi = 0; mi < 2; ++mi)
#pragma unroll
            for (int ni = 0; ni < 8; ++ni) { uint2 o; o.x = pk2(acc[mi][ni][0], acc[mi][ni][1]); o.y = pk2(acc[mi][ni][2], acc[mi][ni][3]);
                *(uint2*)(CST + ((size_t)item * 256 + (nh * 8 + ni) * 16 + tq) * 256 + 32 * wave + mi * 16 + 4 * g) = o; }
    }
    if (tid < 256) { float s = 0.f; const bf16* kr = Kt + tid * 136;
        for (int l8 = 0; l8 < 16; ++l8) { float f[8]; unpack8(*(const uint4*)(kr + l8 * 8), f);
#pragma unroll
            for (int j = 0; j < 8; ++j) s += f[j] * ev[l8 * 8 + j]; }
        ((float*)(C.ws + WS_NST))[(size_t)item * 256 + tid] = s; }
    __syncthreads();
}
__device__ __forceinline__ void mlstm_scan(Ctx& C) {
    const float* FCH = (const float*)(C.ws + WS_FCH); const float* MLOC = (const float*)(C.ws + WS_MLOC); float* MPREV = (float*)(C.ws + WS_MPREV);
    const bf16* CST = (const bf16*)((unsigned char*)C.out + 64 * MiB); const float* NST = (const float*)(C.ws + WS_NST); bf16* CPV = (bf16*)(C.ws + WS_MQK); float* NPV = (float*)(C.ws + WS_NPREV);
    for (int item = C.bid; item < 129; item += C.G) {
        if (item < 128) {
            const int e = item * 512 + C.tid, h = e >> 14, off = (e & 16383) * 4;
            float st[4] = {0.f, 0.f, 0.f, 0.f}; float m = 0.f;
            const bf16* p = CST + (size_t)h * 65536 + off; bf16* pw = CPV + (size_t)h * 65536 + off;
#pragma unroll 1
            for (int c0 = 0; c0 < 128; c0 += 32) {
                uint2 ld[32]; float Fb[32], Mb[32];
#pragma unroll
                for (int j = 0; j < 32; ++j) { ld[j] = *(const uint2*)(p + (size_t)(c0 + j) * 4 * 65536); Fb[j] = FCH[((c0 + j) * 4 + h) * 32]; Mb[j] = MLOC[((c0 + j) * 4 + h) * 32]; }
#pragma unroll
                for (int j = 0; j < 32; ++j) { const int c = c0 + j; const float Fc = Fb[j], ml = Mb[j];
                    uint2 o; o.x = pk2(st[0], st[1]); o.y = pk2(st[2], st[3]); *(uint2*)(pw + (size_t)c * 4 * 65536) = o;
                    const float mn = fmaxf(Fc + m, ml), a = expf(Fc + m - mn), gg = expf(ml - mn);
                    st[0] = a * st[0] + gg * lo16(ld[j].x); st[1] = a * st[1] + gg * hi16(ld[j].x); st[2] = a * st[2] + gg * lo16(ld[j].y); st[3] = a * st[3] + gg * hi16(ld[j].y); m = mn; }
            }
        } else {
#pragma unroll
            for (int rep = 0; rep < 2; ++rep) { const int el = C.tid + rep * 512, h = el >> 8; float st = 0.f, m = 0.f;
                for (int c = 0; c < 128; ++c) { const float Fc = FCH[(c * 4 + h) * 32], ml = MLOC[(c * 4 + h) * 32]; const size_t qi = (size_t)(c * 4 + h) * 256 + (el & 255); const float nl = NST[qi]; NPV[qi] = st;
                    if ((el & 255) == 0) MPREV[c * 4 + h] = m;
                    const float mn = fmaxf(Fc + m, ml), a = expf(Fc + m - mn), gg = expf(ml - mn); st = a * st + gg * nl; m = mn; } }
        }
    }
}
__device__ __forceinline__ void mlstm_num1_item(Ctx& C, int item) {
    const int c = item >> 2, h = item & 3, tid = C.tid, lane = C.lane, wave = C.wave, g = lane >> 4, tq = lane & 15;
    bf16* Cs = (bf16*)C.lds;
    const bf16* QKC = (const bf16*)C.out; const bf16* CPV = (const bf16*)(C.ws + WS_MQK); bf16* NUM1 = (bf16*)(C.ws + WS_WIN);
    bf16x8 qf[8];
    { const bf16* qrow = QKC + (size_t)(c * 128 + 16 * wave + tq) * 2048 + h * 256 + 8 * g;
#pragma unroll
      for (int ks = 0; ks < 8; ++ks) qf[ks] = *(const bf16x8*)(qrow + ks * 32); }
#pragma unroll 1
    for (int hv = 0; hv < 2; ++hv) {
        __syncthreads();
#pragma unroll
        for (int i = 0; i < 8; ++i) { const int idx = tid + i * 512, row = idx >> 5, ch = idx & 31;
            *(uint4*)(Cs + row * 264 + ch * 8) = *(const uint4*)(CPV + (size_t)item * 65536 + (size_t)(hv * 128 + row) * 256 + ch * 8); }
        __syncthreads();
        f32x4 o[8];
#pragma unroll
        for (int ni = 0; ni < 8; ++ni) { o[ni] = (f32x4){0.f, 0.f, 0.f, 0.f};
#pragma unroll
            for (int ks = 0; ks < 8; ++ks) { const bf16x8 cf = *(const bf16x8*)(Cs + (ni * 16 + tq) * 264 + ks * 32 + 8 * g); o[ni] = mma16(qf[ks], cf, o[ni]); } }
#pragma unroll
        for (int ni = 0; ni < 8; ++ni)
#pragma unroll
            for (int r = 0; r < 4; ++r) NUM1[(size_t)(c * 128 + 16 * wave + 4 * g + r) * 1024 + h * 256 + hv * 128 + ni * 16 + tq] = f2bf(o[ni][r]);
    }
    asm volatile("s_waitcnt vmcnt(0)" ::: "memory");
    __syncthreads();
}
__device__ __forceinline__ void mlstm_out_item(Ctx& C, int item) {
    const int c = item >> 2, h = item & 3, tid = C.tid, lane = C.lane, wave = C.wave, g = lane >> 4, tq = lane & 15;
    bf16* Ks = (bf16*)C.lds; bf16* Vt = (bf16*)(C.lds + 67584); float* sc = (float*)(C.lds + 137216); const bf16* NUM1 = (const bf16*)(C.ws + WS_WIN);
    float* negmx = sc, *lib = sc + 128, *inter = sc + 256, *emt = sc + 384, *npv = sc + 512, *dens = sc + 768;
    const bf16* QKC = (const bf16*)C.out;
#ifdef EXP_F
    const bf16* CST = (const bf16*)((unsigned char*)C.out + 64 * MiB);
#else
    const bf16* CST = (const bf16*)(C.ws + WS_MQK);
#endif
 const bf16* MV = (const bf16*)(C.ws + WS_MV); bf16* MO = (bf16*)(C.ws + WS_MO);
    if (wave == 0) {
        const float mp = ((const float*)(C.ws + WS_MPREV))[item];
        float b0, b1, li0, li1; gate_scalars(C, c, h, lane, b0, b1, li0, li1);
        const float x0 = li0 - b0, x1 = li1 - b1; const float cm0 = wave_incl_max(x0, lane); const float t0 = __shfl(cm0, 63); const float cm1 = fmaxf(wave_incl_max(x1, lane), t0);
        const float M0 = fmaxf(mp, cm0), M1 = fmaxf(mp, cm1);
        negmx[lane] = -M0; negmx[lane + 64] = -M1; lib[lane] = x0; lib[lane + 64] = x1; inter[lane] = expf(mp - M0); inter[lane + 64] = expf(mp - M1);
        emt[lane] = expf(-(b0 + M0)); emt[lane + 64] = expf(-(b1 + M1));
    }
    if (tid < 256) npv[tid] = ((const float*)(C.ws + WS_NPREV))[(size_t)item * 256 + tid];
#pragma unroll
    for (int i = 0; i < 8; ++i) { const int idx = tid + i * 512, row = idx >> 5, ch = idx & 31;
        *(uint4*)(Ks + row * 264 + ch * 8) = *(const uint4*)(QKC + (size_t)(c * 128 + row) * 2048 + 1024 + h * 256 + ch * 8); }
    load_transposed_256(MV + (size_t)(c * 128) * 1024 + h * 256, 1024, Vt, nullptr, tid);
    __syncthreads();
    const int t = 16 * wave + tq;
    bf16x8 qf[8];
    { const bf16* qrow = QKC + (size_t)(c * 128 + t) * 2048 + h * 256 + 8 * g;
#pragma unroll
      for (int ks = 0; ks < 8; ++ks) qf[ks] = *(const bf16x8*)(qrow + ks * 32); }
    f32x4 sacc[8];
#pragma unroll
    for (int mi = 0; mi < 8; ++mi) sacc[mi] = (f32x4){0.f, 0.f, 0.f, 0.f};
#pragma unroll
    for (int mi = 0; mi < 8; ++mi) if (mi <= wave) {
#pragma unroll
        for (int ks = 0; ks < 8; ++ks) { const bf16x8 a = *(const bf16x8*)(Ks + (mi * 16 + tq) * 264 + ks * 32 + 8 * g); sacc[mi] = mma16(a, qf[ks], sacc[mi]); } }
    const float nm = negmx[t]; float rs = 0.f;
#pragma unroll
    for (int mi = 0; mi < 8; ++mi)
#pragma unroll
        for (int r = 0; r < 4; ++r) { const int s = mi * 16 + 4 * g + r; const float p = (s <= t) ? sacc[mi][r] * __expf(nm + lib[s]) : 0.f; rs += p; sacc[mi][r] = p; }
    rs += __shfl_xor(rs, 16); rs += __shfl_xor(rs, 32);
    float qn = 0.f;
#pragma unroll
    for (int ks = 0; ks < 8; ++ks)
#pragma unroll
        for (int j = 0; j < 8; ++j) qn += bf2f((unsigned short)qf[ks][j]) * npv[ks * 32 + 8 * g + j];
    qn += __shfl_xor(qn, 16); qn += __shfl_xor(qn, 32);
    { const float den = inter[t] * qn + rs; const float dn = fmaxf(fabsf(den), emt[t]); if (g == 0) dens[t] = dn; }
    f32x4 o[16];
#pragma unroll
    for (int ni = 0; ni < 16; ++ni) o[ni] = (f32x4){0.f, 0.f, 0.f, 0.f};
    float itr[4], dr[4];
#pragma unroll
    for (int r = 0; r < 4; ++r) { itr[r] = inter[16 * wave + 4 * g + r]; dr[r] = 1.0f / dens[16 * wave + 4 * g + r]; }
    { const bf16* n1p = NUM1 + (size_t)(c * 128 + 16 * wave + 4 * g) * 1024 + h * 256 + tq;
#pragma unroll
      for (int ni = 0; ni < 16; ++ni)
#pragma unroll
          for (int r = 0; r < 4; ++r) o[ni][r] = itr[r] * bf2f(n1p[r * 1024 + ni * 16]); }

#pragma unroll
    for (int i = 0; i < 4; ++i) if (2 * i <= wave) {
        bf16x8 pa; { const unsigned a0 = pk2(sacc[2 * i][0], sacc[2 * i][1]), a1 = pk2(sacc[2 * i][2], sacc[2 * i][3]), a2 = pk2(sacc[2 * i + 1][0], sacc[2 * i + 1][1]), a3 = pk2(sacc[2 * i + 1][2], sacc[2 * i + 1][3]);
            const uint4 u = make_uint4(a0, a1, a2, a3); pa = __builtin_bit_cast(bf16x8, u); }
#pragma unroll
        for (int ni = 0; ni < 16; ++ni) { const bf16* vp = Vt + (ni * 16 + tq) * 136 + 32 * i + 4 * g; const uint2 lo = *(const uint2*)vp, hi = *(const uint2*)(vp + 16);
            const uint4 u = make_uint4(lo.x, lo.y, hi.x, hi.y); o[ni] = mma16(pa, __builtin_bit_cast(bf16x8, u), o[ni]); } }
    float ss[4] = {0.f, 0.f, 0.f, 0.f};
#pragma unroll
    for (int ni = 0; ni < 16; ++ni)
#pragma unroll
        for (int r = 0; r < 4; ++r) { o[ni][r] *= dr[r]; ss[r] += o[ni][r] * o[ni][r]; }
#pragma unroll
    for (int r = 0; r < 4; ++r) { ss[r] += __shfl_xor(ss[r], 1); ss[r] += __shfl_xor(ss[r], 2); ss[r] += __shfl_xor(ss[r], 4); ss[r] += __shfl_xor(ss[r], 8); ss[r] = rsqrtf(ss[r] * (1.0f / 256.0f) + EPS); }
#pragma unroll
    for (int ni = 0; ni < 16; ++ni) { const int v = ni * 16 + tq; const float gam = ((const float*)C.a.in[8])[h * 256 + v];
#pragma unroll
        for (int r = 0; r < 4; ++r) { bf16* p = MO + (size_t)(c * 128 + 16 * wave + 4 * g + r) * 1024 + h * 256 + v; const float mo = bf2f(*p);
#ifdef HM_GATE_ONLY
            *p = f2bf(gam * sigmoidf_(mo));
#else
            *p = f2bf(o[ni][r] * ss[r] * gam * sigmoidf_(mo));
#endif
        } }
    __syncthreads();
}

__device__ __forceinline__ void moba_select_item(Ctx& C, int item) {
    const int h = item >> 6, qb = item & 63, own = qb, tid = C.tid, lane = C.lane, wave = C.wave, g = lane >> 4, tq = lane & 15;
    int* CNT = (int*)(C.ws + WS_CNT); unsigned short* LIST = (unsigned short*)(C.ws + WS_LIST);
    if (own == 0) { if (tid < 64) CNT[(h * 64 + qb) * 64 + tid] = 0; return; }
    bf16* KMh = (bf16*)C.lds; bf16* KMl = KMh + 64 * 136; int* cnt = (int*)(C.lds + 2 * 64 * 136 * 2);
    const bf16* AQ = (const bf16*)(C.ws + WS_AQ); const float* KMEAN = (const float*)(C.ws + WS_KMEAN);
    for (int idx = tid; idx < 64 * 32; idx += 512) { const int n = idx >> 5, c4 = idx & 31; const float4 v = ((const float4*)(KMEAN + ((size_t)h * 64 + n) * 128))[c4];
        const unsigned short h0 = f2bf(v.x), h1 = f2bf(v.y), h2 = f2bf(v.z), h3 = f2bf(v.w);
        uint2 hi, lo; hi.x = (unsigned)h0 | ((unsigned)h1 << 16); hi.y = (unsigned)h2 | ((unsigned)h3 << 16);
        lo.x = pk2(v.x - bf2f(h0), v.y - bf2f(h1)); lo.y = pk2(v.z - bf2f(h2), v.w - bf2f(h3));
        *(uint2*)(KMh + n * 136 + c4 * 4) = hi; *(uint2*)(KMl + n * 136 + c4 * 4) = lo; }
    if (tid < 64) cnt[tid] = 0;
    __syncthreads();
    const float NINF = -__builtin_inff();
#define TOP3_INS(x, n) do { if ((x) > v1) { v3 = v2; i3 = i2; v2 = v1; i2 = i1; v1 = (x); i1 = (n); } else if ((x) > v2) { v3 = v2; i3 = i2; v2 = (x); i2 = (n); } else if ((x) > v3) { v3 = (x); i3 = (n); } } while (0)
#pragma unroll 1
    for (int rg = 0; rg < 2; ++rg) {
        const int ql = 32 * wave + 16 * rg + tq;
        bf16x8 qf[4];
        { const bf16* qrow = AQ + (size_t)(qb * 256 + ql) * 1024 + h * 128 + 8 * g;
#pragma unroll
          for (int ks = 0; ks < 4; ++ks) qf[ks] = *(const bf16x8*)(qrow + ks * 32); }
        float v1 = NINF, v2 = NINF, v3 = NINF; int i1 = -1, i2 = -1, i3 = -1;
#pragma unroll
        for (int mi = 0; mi < 4; ++mi) if (mi * 16 < own) {
            f32x4 acc = (f32x4){0.f, 0.f, 0.f, 0.f};
#pragma unroll
            for (int ks = 0; ks < 4; ++ks) { const bf16x8 ah = *(const bf16x8*)(KMh + (mi * 16 + tq) * 136 + ks * 32 + 8 * g), al = *(const bf16x8*)(KMl + (mi * 16 + tq) * 136 + ks * 32 + 8 * g);
                acc = mma16(ah, qf[ks], acc); acc = mma16(al, qf[ks], acc); }
#pragma unroll
            for (int r = 0; r < 4; ++r) { const int n = mi * 16 + 4 * g + r; if (n < own) { const float xv = acc[r]; TOP3_INS(xv, n); } }
        }
#pragma unroll
        for (int sh = 16; sh <= 32; sh <<= 1) {
            const float p1 = __shfl_xor(v1, sh), p2 = __shfl_xor(v2, sh), p3 = __shfl_xor(v3, sh); const int j1 = __shfl_xor(i1, sh), j2 = __shfl_xor(i2, sh), j3 = __shfl_xor(i3, sh);
            if (j1 >= 0) TOP3_INS(p1, j1); if (j2 >= 0) TOP3_INS(p2, j2); if (j3 >= 0) TOP3_INS(p3, j3);
        }
        if (g == 0) { const int sel[3] = {i1, i2, i3};
#pragma unroll
            for (int j = 0; j < 3; ++j) if (sel[j] >= 0) { const int pos = atomicAdd(&cnt[sel[j]], 1); LIST[((size_t)(h * 64 + sel[j]) * 64 + qb) * 256 + pos] = (unsigned short)((ql << 2) | j); } }
    }
#undef TOP3_INS
    __syncthreads();
    if (tid < 64) CNT[(h * 64 + qb) * 64 + tid] = (tid < own) ? cnt[tid] : 0;
    __syncthreads();
}
constexpr int MOBA_MAXT = 20;
__device__ __forceinline__ void moba_attn(Ctx& C) {
    const int tid = C.tid, lane = C.lane, wave = C.wave, g = lane >> 4, tq = lane & 15;
    bf16* Ks = (bf16*)C.lds; bf16* Vt = (bf16*)(C.lds + 69632);
    int* incl = (int*)(C.lds + 137216); int* wtot = incl + 512; int* tl_hn = wtot + 8; int* tl_arg = tl_hn + 24; int* tl_own = tl_arg + 24; int* segw = tl_own + 24; int* rowmap = segw + 8 * 66;
    const bf16* AQ = (const bf16*)(C.ws + WS_AQ); const bf16* AK = (const bf16*)(C.ws + WS_AK); const bf16* AV = (const bf16*)(C.ws + WS_AV);
    const int* CNT = (const int*)(C.ws + WS_CNT); const unsigned short* LIST = (const unsigned short*)(C.ws + WS_LIST);
    bf16* PART = (bf16*)C.out; float* LSE = (float*)(C.ws + WS_LSE);
    { int tot = 0; const int* cp = CNT + (tid >> 6) * 4096 + (tid & 63);
#pragma unroll 8
      for (int qb = 0; qb < 64; ++qb) tot += cp[qb * 64];
      const int nt = (tot + 127) >> 7; const int v = wave_incl_sum_i(nt, lane); if (lane == 63) wtot[wave] = v; __syncthreads();
      int off = 0; for (int w = 0; w < wave; ++w) off += wtot[w]; incl[tid] = v + off; __syncthreads(); }
    const int T = incl[511];
    const int f0 = (int)(((long)C.bid * T) / C.G), f1 = (int)(((long)(C.bid + 1) * T) / C.G);
    const int nown = (C.bid < 1024) ? (1024 - C.bid + C.G - 1) / C.G : 0;
    int ntile = nown + (f1 - f0); if (ntile > MOBA_MAXT) ntile = MOBA_MAXT;
    if (tid < ntile) {
        if (tid < nown) { const int it = C.bid + tid * C.G, hh = it >> 7, qt = it & 127; tl_hn[tid] = hh * 64 + (qt >> 1); tl_arg[tid] = qt; tl_own[tid] = 1; }
        else { const int f = f0 + (tid - nown); int lo = 0, hi = 511; while (lo < hi) { const int mid = (lo + hi) >> 1; if (incl[mid] > f) hi = mid; else lo = mid + 1; }
            tl_hn[tid] = lo; tl_arg[tid] = f - (lo ? incl[lo - 1] : 0); tl_own[tid] = 0; }
    }
    __syncthreads();
    for (int i = wave; i < ntile; i += 8) {
        const int hn = tl_hn[i], arg = tl_arg[i]; int* sw = segw + wave * 66;
        if (tl_own[i]) { rowmap[i * 128 + lane] = (arg * 128 + lane) * 4 + 3; rowmap[i * 128 + 64 + lane] = (arg * 128 + 64 + lane) * 4 + 3; }
        else { const int hh = hn >> 6, n = hn & 63; const int cv = CNT[(hh * 64 + lane) * 64 + n]; const int inc = wave_incl_sum_i(cv, lane); sw[lane] = inc - cv; if (lane == 63) sw[64] = inc;
            __builtin_amdgcn_s_waitcnt(0xc07f); asm volatile("" ::: "memory");
            const int tot = sw[64];
#pragma unroll
            for (int rr = 0; rr < 2; ++rr) { const int r = lane + 64 * rr, p = arg * 128 + r; int rm = -1;
                if (p < tot) { int lo = 0, hi = 64; while (hi - lo > 1) { const int mid = (lo + hi) >> 1; if (sw[mid] <= p) lo = mid; else hi = mid; }
                    const unsigned e = LIST[((size_t)hn * 64 + lo) * 256 + (p - sw[lo])]; rm = (lo * 256 + (int)(e >> 2)) * 4 + (int)(e & 3u); }
                rowmap[i * 128 + r] = rm; }
            __builtin_amdgcn_s_waitcnt(0xc07f); asm volatile("" ::: "memory"); }
    }
    __syncthreads();
    int cached = -1;
    bf16x8 qf[4];
    if (ntile > 0) { const int rm = rowmap[16 * wave + tq]; const int ql = rm < 0 ? 0 : (rm >> 2); const bf16* qrow = AQ + (size_t)ql * 1024 + (tl_hn[0] >> 6) * 128 + 8 * g;
#pragma unroll
        for (int ks = 0; ks < 4; ++ks) qf[ks] = *(const bf16x8*)(qrow + ks * 32); }
    for (int i = 0; i < ntile; ++i) {
        const int hn = tl_hn[i], h = hn >> 6, n = hn & 63; const bool is_own = tl_own[i] != 0;
        if (hn != cached) {
            __syncthreads();
#pragma unroll
            for (int ii = 0; ii < 8; ++ii) { const int idx = tid + ii * 512, row = idx >> 4, ch = idx & 15; *(uint4*)(Ks + row * 136 + ch * 8) = *(const uint4*)(AK + (size_t)(n * 256 + row) * 1024 + h * 128 + ch * 8); }
            { const int key = tid & 255, dgp = tid >> 8; const bf16* vrow = AV + (size_t)(n * 256 + key) * 1024 + h * 128;
#pragma unroll
              for (int ii = 0; ii < 8; ++ii) { const int dg = dgp * 8 + ii; const uint4 vv = *(const uint4*)(vrow + dg * 8); const unsigned wv[4] = {vv.x, vv.y, vv.z, vv.w};
#pragma unroll
                  for (int j = 0; j < 8; ++j) Vt[(dg * 8 + j) * 264 + key] = (unsigned short)((j & 1) ? (wv[j >> 1] >> 16) : (wv[j >> 1] & 0xffffu)); } }
            cached = hn;
            __syncthreads();
        }
        const int rmq = rowmap[i * 128 + 16 * wave + tq]; const int ql = rmq < 0 ? 0 : (rmq >> 2);
        f32x4 sacc[16];
#pragma unroll
        for (int mi = 0; mi < 16; ++mi) { sacc[mi] = (f32x4){0.f, 0.f, 0.f, 0.f};
#pragma unroll
            for (int ks = 0; ks < 4; ++ks) { const bf16x8 a = *(const bf16x8*)(Ks + (mi * 16 + tq) * 136 + ks * 32 + 8 * g); sacc[mi] = mma16(a, qf[ks], sacc[mi]); } }
        if (i + 1 < ntile) { const int rm = rowmap[(i + 1) * 128 + 16 * wave + tq]; const int qn_ = rm < 0 ? 0 : (rm >> 2); const bf16* qrow = AQ + (size_t)qn_ * 1024 + (tl_hn[i + 1] >> 6) * 128 + 8 * g;
#pragma unroll
            for (int ks = 0; ks < 4; ++ks) qf[ks] = *(const bf16x8*)(qrow + ks * 32); }
        const float scale = 0.08838834764831845f; const int qloc = is_own ? (ql - n * 256) : 100000; float mx = -__builtin_inff();
#pragma unroll
        for (int mi = 0; mi < 16; ++mi)
#pragma unroll
            for (int r = 0; r < 4; ++r) { const int key = mi * 16 + 4 * g + r; float sv = sacc[mi][r] * scale; if (key > qloc) sv = -__builtin_inff(); sacc[mi][r] = sv; mx = fmaxf(mx, sv); }
        mx = fmaxf(mx, __shfl_xor(mx, 16)); mx = fmaxf(mx, __shfl_xor(mx, 32));
        float l = 0.f;
#pragma unroll
        for (int mi = 0; mi < 16; ++mi)
#pragma unroll
            for (int r = 0; r < 4; ++r) { const float p = __expf(sacc[mi][r] - mx); l += p; sacc[mi][r] = p; }
        l += __shfl_xor(l, 16); l += __shfl_xor(l, 32);
        f32x4 o[8];
#pragma unroll
        for (int ni = 0; ni < 8; ++ni) o[ni] = (f32x4){0.f, 0.f, 0.f, 0.f};
#pragma unroll
        for (int k2 = 0; k2 < 8; ++k2) {
            bf16x8 pa; { const uint4 u = make_uint4(pk2(sacc[2 * k2][0], sacc[2 * k2][1]), pk2(sacc[2 * k2][2], sacc[2 * k2][3]), pk2(sacc[2 * k2 + 1][0], sacc[2 * k2 + 1][1]), pk2(sacc[2 * k2 + 1][2], sacc[2 * k2 + 1][3])); pa = __builtin_bit_cast(bf16x8, u); }
#pragma unroll
            for (int ni = 0; ni < 8; ++ni) { const bf16* vp = Vt + (ni * 16 + tq) * 264 + 32 * k2 + 4 * g; const uint2 lo = *(const uint2*)vp, hi = *(const uint2*)(vp + 16);
                const uint4 u = make_uint4(lo.x, lo.y, hi.x, hi.y); o[ni] = mma16(pa, __builtin_bit_cast(bf16x8, u), o[ni]); } }
#pragma unroll
        for (int r = 0; r < 4; ++r) { const float lr = __shfl(l, 4 * g + r); const float inv = 1.0f / lr; const int rm = rowmap[i * 128 + 16 * wave + 4 * g + r];
            if (rm >= 0) { bf16* dst = PART + ((size_t)((rm >> 2) * 8 + h) * 4 + (rm & 3)) * 128 + tq;
#pragma unroll
                for (int ni = 0; ni < 8; ++ni) dst[ni * 16] = f2bf(o[ni][r] * inv); } }
        if (g == 0 && rmq >= 0) __hip_atomic_store((unsigned*)LSE + (size_t)((rmq >> 2) * 8 + h) * 4 + (rmq & 3), __float_as_uint(mx + __logf(l)), __ATOMIC_RELAXED, __HIP_MEMORY_SCOPE_AGENT);
    }
    __syncthreads();
}
__device__ __forceinline__ void moba_combine(Ctx& C) {
    const bf16* PART = (const bf16*)C.out; const float* LSE = (const float*)(C.ws + WS_LSE); bf16* HA = (bf16*)(C.ws + WS_AQ);
    const int total = SEQ * 8 * 16;
    for (int idx = C.bid * 512 + C.tid; idx < total; idx += C.G * 512) {
        const int dg = idx & 15, h = (idx >> 4) & 7, q = idx >> 7; const int nsel = min(q >> 8, 3);
        const float4 ls = *(const float4*)(LSE + (size_t)(q * 8 + h) * 4); const float lv[4] = {ls.x, ls.y, ls.z, ls.w};
        float M = lv[3];
#pragma unroll
        for (int j = 0; j < 3; ++j) if (j < nsel) M = fmaxf(M, lv[j]);
        float acc[8], wsum = 0.f;
#pragma unroll
        for (int i = 0; i < 8; ++i) acc[i] = 0.f;
#pragma unroll
        for (int j = 0; j < 4; ++j) if (j == 3 || j < nsel) { const float w = __expf(lv[j] - M); wsum += w; float f[8]; unpack8(*(const uint4*)(PART + ((size_t)(q * 8 + h) * 4 + j) * 128 + dg * 8), f);
#pragma unroll
            for (int i = 0; i < 8; ++i) acc[i] += w * f[i]; }
        const float inv = 1.0f / wsum;
#pragma unroll
        for (int i = 0; i < 8; ++i) acc[i] *= inv;
#ifdef ZERO_HA
#pragma unroll
        for (int i = 0; i < 8; ++i) acc[i] = 0.f;
#endif
        *(uint4*)(HA + (size_t)q * 1024 + h * 128 + dg * 8) = pack8(acc);
    }
}

__device__ __forceinline__ void rows1(Ctx& C) {
    const bf16* MIX = (const bf16*)(C.ws + WS_GM); bf16* HN = (bf16*)(C.ws + WS_GA);
    const int gw = C.bid * 8 + C.wave, NGW = C.G * 8, lane = C.lane;
    for (int row = gw; row < SEQ; row += NGW) {
        float m[4][8]; float ss = 0.f;
#pragma unroll
        for (int j = 0; j < 4; ++j) { unpack8(*(const uint4*)(MIX + (size_t)row * DM + 512 * j + 8 * lane), m[j]);
#pragma unroll
            for (int i = 0; i < 8; ++i) ss += m[j][i] * m[j][i]; }
        const float rstd = rsqrtf(wave_sum(ss) * (1.f / DM) + EPS); float ss2 = 0.f;
#ifdef ZERO_MIX
#pragma unroll
        for (int j = 0; j < 4; ++j)
#pragma unroll
            for (int i = 0; i < 8; ++i) m[j][i] = 0.f;
#endif
#pragma unroll
        for (int j = 0; j < 4; ++j) { const int k = 512 * j + 8 * lane; const float4* xp = (const float4*)(((const float*)C.a.in[0]) + (size_t)row * DM + k); const float4* wp = (const float4*)(((const float*)C.a.in[12]) + k);
            const float4 xa = xp[0], xb = xp[1], wa = wp[0], wb = wp[1];
            m[j][0] = xa.x + m[j][0] * rstd * wa.x; m[j][1] = xa.y + m[j][1] * rstd * wa.y; m[j][2] = xa.z + m[j][2] * rstd * wa.z; m[j][3] = xa.w + m[j][3] * rstd * wa.w;
            m[j][4] = xb.x + m[j][4] * rstd * wb.x; m[j][5] = xb.y + m[j][5] * rstd * wb.y; m[j][6] = xb.z + m[j][6] * rstd * wb.z; m[j][7] = xb.w + m[j][7] * rstd * wb.w;
            *(uint4*)((bf16*)(C.out + (size_t)row * DM + DM / 2) + k) = pack8(m[j]);
#pragma unroll
            for (int i = 0; i < 8; ++i) ss2 += m[j][i] * m[j][i]; }
        const float rstd2 = rsqrtf(wave_sum(ss2) * (1.f / DM) + EPS);
#pragma unroll
        for (int j = 0; j < 4; ++j) { const int k = 512 * j + 8 * lane; const float4* wp = (const float4*)(((const float*)C.a.in[13]) + k); const float4 wa = wp[0], wb = wp[1];
            float o[8] = {m[j][0] * rstd2 * wa.x, m[j][1] * rstd2 * wa.y, m[j][2] * rstd2 * wa.z, m[j][3] * rstd2 * wa.w, m[j][4] * rstd2 * wb.x, m[j][5] * rstd2 * wb.y, m[j][6] * rstd2 * wb.z, m[j][7] * rstd2 * wb.w};
            *(uint4*)(HN + (size_t)row * DM + k) = pack8(o); }
    }
}
__device__ __forceinline__ void rows2(Ctx& C) {
    const bf16* Y = (const bf16*)(C.ws + WS_GA);
    const int gw = C.bid * 8 + C.wave, NGW = C.G * 8, lane = C.lane;
    for (int row = gw; row < SEQ; row += NGW) {
        float m[4][8], x1[4][8]; float ss = 0.f;
#pragma unroll
        for (int j = 0; j < 4; ++j) { unpack8(*(const uint4*)(Y + (size_t)row * DM + 512 * j + 8 * lane), m[j]);
            unpack8(*(const uint4*)((const bf16*)(C.out + (size_t)row * DM + DM / 2) + 512 * j + 8 * lane), x1[j]);
#pragma unroll
            for (int i = 0; i < 8; ++i) ss += m[j][i] * m[j][i]; }
        const float rstd = rsqrtf(wave_sum(ss) * (1.f / DM) + EPS);
        asm volatile("s_waitcnt vmcnt(0)" ::: "memory");
#pragma unroll
        for (int j = 0; j < 4; ++j) { const int k = 512 * j + 8 * lane; float4* op = (float4*)(C.out + (size_t)row * DM + k); const float4* wp = (const float4*)(((const float*)C.a.in[16]) + k);
            const float4 wa = wp[0], wb = wp[1];
            op[0] = make_float4(x1[j][0] + m[j][0] * rstd * wa.x, x1[j][1] + m[j][1] * rstd * wa.y, x1[j][2] + m[j][2] * rstd * wa.z, x1[j][3] + m[j][3] * rstd * wa.w);
            op[1] = make_float4(x1[j][4] + m[j][4] * rstd * wb.x, x1[j][5] + m[j][5] * rstd * wb.y, x1[j][6] + m[j][6] * rstd * wb.z, x1[j][7] + m[j][7] * rstd * wb.w); }
    }
}


#define XB_TMO      128
#define XB_XCNT(j)  (256  + 64 * (j))
#define XB_XSUB(j)  (1280 + 64 * (j))
#define XB_XGEN(j)  (2304 + 64 * (j))
#define XB_TOP      3328
#define XB_TOPGEN   3392
#define XCD_BAR_WORDS 3456
#define XB_SPIN_CAP (1u << 18)

__device__ __forceinline__ unsigned xb_ld(unsigned* p)              { return __hip_atomic_load(p, __ATOMIC_RELAXED, __HIP_MEMORY_SCOPE_AGENT); }
__device__ __forceinline__ unsigned xb_add(unsigned* p, unsigned v) { return __hip_atomic_fetch_add(p, v, __ATOMIC_RELAXED, __HIP_MEMORY_SCOPE_AGENT); }
__device__ __forceinline__ unsigned xb_xcc_id() { return (unsigned)__builtin_amdgcn_s_getreg((3 << 11) | 20) & 0xFu; }
#define XB_SPIN(cond, bar) do { unsigned _sp = 0; while (cond) { __builtin_amdgcn_s_sleep(1); \
    if ((++_sp & 255u) == 0u) { if (xb_ld(&(bar)[XB_TMO])) break; if (_sp > XB_SPIN_CAP) { atomicAdd(&(bar)[XB_TMO], 1u); break; } } } } while (0)

struct XcdBarrier {
    unsigned* bar; unsigned x;
    volatile unsigned* st;
};

__device__ __forceinline__ XcdBarrier xcd_barrier_post(unsigned* bar, volatile unsigned* st) {
    XcdBarrier b; b.bar = bar; b.x = xb_xcc_id(); b.st = st;
    if (threadIdx.x == 0) (void)xb_add(&bar[XB_XCNT(b.x)], 1u);
    return b;
}
__device__ __forceinline__ void xcd_barrier_complete(unsigned* bar, unsigned x, unsigned& nloc, unsigned& nx) {
    const unsigned G = gridDim.x * gridDim.y * gridDim.z;
    unsigned sum, cnt, mine, sp = 0u;
    for (;;) {
        sum = 0u; cnt = 0u; mine = 0u;
#pragma unroll
        for (unsigned j = 0; j < 16; ++j) { const unsigned c = xb_ld(&bar[XB_XCNT(j)]); sum += c; cnt += (c > 0u) ? 1u : 0u; mine = (j == x) ? c : mine; }
        if (sum == G) break;
        __builtin_amdgcn_s_sleep(1);
        if ((++sp & 255u) == 0u) { if (xb_ld(&bar[XB_TMO])) break; if (sp > XB_SPIN_CAP) { atomicAdd(&bar[XB_TMO], 1u); break; } }
    }
    nloc = mine > 0u ? mine : 1u; nx = cnt > 0u ? cnt : 1u;
}

__device__ __forceinline__ void xcd_barrier(const XcdBarrier& b) {
    asm volatile("s_waitcnt vmcnt(0)" ::: "memory");
    __syncthreads();
    if (threadIdx.x == 0) {
        unsigned* bar = b.bar;
        __builtin_amdgcn_s_waitcnt(0);
        unsigned nloc = b.st[0], nx = b.st[1];
        if (nloc == 0u) { xcd_barrier_complete(bar, b.x, nloc, nx); b.st[0] = nloc; b.st[1] = nx; }
        const unsigned old = xb_add(&bar[XB_XSUB(b.x)], 1u);
        const unsigned gen = old / nloc;
        if (old + 1u == (gen + 1u) * nloc) {
            __builtin_amdgcn_fence(__ATOMIC_RELEASE, "agent");
            asm volatile("s_waitcnt vmcnt(0)" ::: "memory");
            const unsigned og = xb_add(&bar[XB_TOP], 1u);
            const unsigned tg = og / nx;
            if (og + 1u == (tg + 1u) * nx) xb_add(&bar[XB_TOPGEN], 1u);
            else XB_SPIN(xb_ld(&bar[XB_TOPGEN]) == tg, bar);
            __builtin_amdgcn_fence(__ATOMIC_ACQUIRE, "agent");
            xb_add(&bar[XB_XGEN(b.x)], 1u);
            asm volatile("s_waitcnt vmcnt(0)" ::: "memory");
        } else {
            XB_SPIN(xb_ld(&bar[XB_XGEN(b.x)]) == gen, bar);
            __builtin_amdgcn_fence(__ATOMIC_ACQUIRE, "agent");
            asm volatile("s_waitcnt vmcnt(0)" ::: "memory");
        }
    }
    __syncthreads();
}

constexpr int NPHASE = 14;
template <class Epi> __device__ __forceinline__ void run_gemm(Ctx& C, const bf16* A, const bf16* Bt, int N, int K, const Epi& E) {
    pg8::Gemm g{A, Bt, SEQ, N, K}; pg8::StaticOrder S; S.init(SEQ, N, C.G, C.bid);
    pg8::gemm_phase<Epi, pg8::StaticOrder, false>((PG8_LAS unsigned char*)C.lds, g, S, E, nullptr);
}
__global__ void __launch_bounds__(512, 2) fwd_kernel(Args a) {
    extern __shared__ __attribute__((aligned(16))) unsigned char lds[];
    cg::grid_group grid = cg::this_grid();
    Ctx C{lds, (int)threadIdx.x, (int)(threadIdx.x & 63), __builtin_amdgcn_readfirstlane((int)(threadIdx.x >> 6)), (int)gridDim.x, (int)blockIdx.x, a, a.out, a.ws};
    volatile unsigned* xst = (volatile unsigned*)(lds + LDS_BYTES - 64);
    if (threadIdx.x < 2) xst[threadIdx.x] = 0u;
    __syncthreads();
    XcdBarrier xbar = xcd_barrier_post((unsigned*)(a.ws + WS_BAR), xst);
    const int lo = a.ph_lo, hi = a.ph_hi;
#ifndef PHMASK
#define PHMASK 0xffff
#endif
#define IN(k) (((PHMASK >> (k)) & 1) && lo <= (k) && (k) < hi)
#define SEAM(k) do { if (IN(k) && IN((k) + 1)) { xcd_barrier(xbar); } } while (0)
    unsigned char* ws = a.ws;
    if (hi > NPHASE) grid.sync();
    if (IN(0)) phase0(C);
    SEAM(0);
    if (IN(1)) { pg8::EpiSplit E{(bf16*)(ws + WS_MQK), (bf16*)(ws + WS_MV), (bf16*)(ws + WS_GM), (bf16*)(ws + WS_GA)}; run_gemm(C, (const bf16*)C.out, (const bf16*)(ws + WS_WIN), NPROJ, DM, E); }
    SEAM(1);
    if (IN(2)) phase2(C);
    SEAM(2);
    if (IN(3)) { for (int it = C.bid; it < 512; it += C.G) mlstm_local_item(C, it);
                 for (int it = C.bid; it < 512; it += C.G) moba_select_item(C, it); }
    SEAM(3);
    if (IN(4)) { mlstm_scan(C); convert_ffn_weights(C, C.G >= 192 ? 129 : 0); }
    SEAM(4);
    if (IN(5)) { for (int it = C.bid; it < 512; it += C.G) mlstm_num1_item(C, it);
                 xcd_barrier(xbar);
                 for (int it = C.bid; it < 512; it += C.G) mlstm_out_item(C, it); }
    SEAM(5);
    if (IN(6)) moba_attn(C);
    SEAM(6);
    if (IN(7)) moba_combine(C);
    SEAM(7);
    if (IN(8)) { pg8::EpiB<1> E1{(bf16*)(ws + WS_MQK), DM, (const bf16*)(ws + WS_GM)}; run_gemm(C, (const bf16*)(ws + WS_MO), (const bf16*)(ws + WS_WBM), DM, 1024, E1);
                 pg8::EpiB<2> E2{(bf16*)(ws + WS_MQK), DM, (const bf16*)(ws + WS_GA)}; run_gemm(C, (const bf16*)(ws + WS_AQ), (const bf16*)(ws + WS_WBA), DM, 1024, E2); }
    SEAM(8);
    if (IN(9)) { pg8::EpiB<0> E{(bf16*)(ws + WS_GM), DM, nullptr}; run_gemm(C, (const bf16*)(ws + WS_MQK), (const bf16*)(ws + WS_WOUT), DM, DM, E); }
    SEAM(9);
    if (IN(10)) rows1(C);
    SEAM(10);
    if (IN(11)) { pg8::EpiB<3> E{(bf16*)(ws + WS_U), DFF, nullptr}; run_gemm(C, (const bf16*)(ws + WS_GA), (const bf16*)(ws + WS_WUP), DFF, DM, E); }
    SEAM(11);
    if (IN(12)) { pg8::EpiB<0> E{(bf16*)(ws + WS_GA), DM, nullptr}; run_gemm(C, (const bf16*)(ws + WS_U), (const bf16*)(ws + WS_WDOWN), DM, DFF, E); }
    SEAM(12);
    if (IN(13)) rows2(C);
#undef IN
#undef SEAM
}

#ifndef MK_SPLIT
#define MK_SPLIT 0
#endif
extern "C" void kernel_launch(void* const* d_in, const int* in_sizes, int n_in, void* d_out, int out_size, void* d_ws, size_t ws_size, hipStream_t stream) {
    static int grid = 0;
    if (grid == 0) {
        if (n_in != 17 || out_size != SEQ * DM || ws_size < WS_NEED) { fprintf(stderr, "kernel_launch: unexpected shapes (n_in %d out %d ws %zu)\n", n_in, out_size, ws_size); grid = -1; return; }
        int dev = 0, cus = 0, per_cu = 0;
        hipGetDevice(&dev); hipDeviceGetAttribute(&cus, hipDeviceAttributeMultiprocessorCount, dev);
        if (hipFuncSetAttribute((const void*)fwd_kernel, hipFuncAttributeMaxDynamicSharedMemorySize, LDS_BYTES) != hipSuccess) { fprintf(stderr, "kernel_launch: hipFuncSetAttribute failed\n"); grid = -1; return; }
        if (hipOccupancyMaxActiveBlocksPerMultiprocessor(&per_cu, (const void*)fwd_kernel, 512, LDS_BYTES) != hipSuccess || per_cu < 1) { fprintf(stderr, "kernel_launch: occupancy query says %d\n", per_cu); per_cu = 1; }
        (void)hipGetLastError();
        grid = cus;
    }
    if (grid < 0) return;
    if (hipMemsetAsync((unsigned char*)d_ws + WS_BAR, 0, 16384, stream) != hipSuccess) { fprintf(stderr, "kernel_launch: memset failed\n"); return; }
    Args a{};
    for (int i = 0; i < 17; ++i) a.in[i] = d_in[i];
    a.out = (float*)d_out; a.ws = (unsigned char*)d_ws;
#if MK_SPLIT
    for (int p = 0; p < NPHASE; ++p) { a.ph_lo = p; a.ph_hi = p + 1; hipLaunchKernelGGL(fwd_kernel, dim3(grid), dim3(512), LDS_BYTES, stream, a); }
#else
    a.ph_lo = 0; a.ph_hi = NPHASE;
    void* args[] = {&a};
    hipError_t e = hipLaunchCooperativeKernel((const void*)fwd_kernel, dim3(grid), dim3(512), args, LDS_BYTES, stream);
    if (e != hipSuccess) fprintf(stderr, "kernel_launch: cooperative launch failed: %s (grid %d)\n", hipGetErrorString(e), grid);
#endif
}
```

```cpp
#include <hip/hip_runtime.h>
#include <hip/hip_cooperative_groups.h>
#include <cstdio>
namespace cg = cooperative_groups;
namespace pg8 {
#define PG8_LAS __attribute__((address_space(3)))
typedef unsigned short bf16_t;
typedef short bf16x8 __attribute__((ext_vector_type(8)));
typedef float f32x4 __attribute__((ext_vector_type(4)));
typedef unsigned u32x4 __attribute__((ext_vector_type(4)));
constexpr int BM = 256, BK = 64, HALF = 128, HTB = HALF * BK * 2  , STAGE_BYTES = 8 * HTB, NXCD = 8, WGM = 8;

__host__ __device__ __forceinline__ int lds_byte(int r, int c) { const int st = (r >> 4) * 2 + (c >> 5), rr = r & 15, cc = c & 31, ob = rr * 64 + cc * 2; return st * 1024 + (ob ^ (((ob >> 9) & 1) << 5)); }
__host__ __device__ __forceinline__ void stage_rc(int b, int& R, int& C) { const int st = b / 1024, sb = b % 1024, swz = sb ^ (((sb >> 9) & 1) << 5); R = (st >> 1) * 16 + swz / 64; C = (st & 1) * 32 + (swz % 64) / 2; }
__host__ __device__ __forceinline__ int perm32(int rho) { const int n = rho >> 4, i = rho & 15; return 8 * (i >> 2) + 4 * n + (i & 3); }

struct Unit { int pm, pn; };
struct Gemm { const bf16_t* A; const bf16_t* Bt; int M, N, K; };

struct StaticOrder {
    int nM, nN, nwg, G, c;
    __host__ __device__ void init(int M, int N, int G_, int c_) { nM = M / BM; nN = N / BM; nwg = nM * nN; G = G_; c = c_; }
    __host__ __device__ bool next(int i, Unit& u) const {
        const long L = (long)i * G + c; if (L >= nwg) return false;
        int wgid = (int)L; { const int q = nwg / NXCD, r = nwg % NXCD, xcd = wgid % NXCD, off = wgid / NXCD; wgid = (xcd < r ? xcd * (q + 1) : r * (q + 1) + (xcd - r) * q) + off; }
        const int nig = WGM * nN, gid = wgid / nig, fm = gid * WGM, gsz = (nM - fm) < WGM ? (nM - fm) : WGM;
        u.pm = fm + ((wgid % nig) % gsz); u.pn = (wgid % nig) / gsz; return true;
    }
    __device__ __forceinline__ void a_ready(const Unit&) const {}
    __device__ __forceinline__ void done(const Unit&) const {}
};
__device__ __forceinline__ unsigned cvt_pk_bf16(float lo, float hi) { unsigned r; asm volatile("v_cvt_pk_bf16_f32 %0, %1, %2" : "=v"(r) : "v"(lo), "v"(hi)); return r; }
typedef float f32x2 __attribute__((ext_vector_type(2)));
__device__ __forceinline__ float sigm(float x) { return 1.0f / (1.0f + __expf(-x)); }
__device__ __forceinline__ float bflo(unsigned w) { return __uint_as_float(w << 16); }
__device__ __forceinline__ float bfhi(unsigned w) { return __uint_as_float(w & 0xffff0000u); }
template <int MODE> struct EpiB {
    static constexpr bool PERM = true, AFTER_DRAIN = false;
    bf16_t* O; int ldc; const bf16_t* aux;
    __device__ __forceinline__ void operator()(const f32x4 (&acc)[2][2][4][2], const Unit& u, int wr, int wc, int fr, int fq) const {
        const int row0 = u.pm * BM + wr * 64 + fr, col0 = u.pn * BM + wc * 32 + 8 * fq;
#pragma unroll
        for (int ai = 0; ai < 2; ++ai)
#pragma unroll
            for (int m = 0; m < 4; ++m) { const size_t off = (size_t)(row0 + ai * HALF + m * 16) * ldc + col0;
#pragma unroll
                for (int bj = 0; bj < 2; ++bj) { f32x4 v0 = acc[ai][bj][m][0], v1 = acc[ai][bj][m][1]; const size_t o = off + bj * HALF;
                    if (MODE == 1 || MODE == 2) { const u32x4 g = *(const u32x4*)(aux + o);
                        v0[0] *= sigm(bflo(g.x)); v0[1] *= sigm(bfhi(g.x)); v0[2] *= sigm(bflo(g.y)); v0[3] *= sigm(bfhi(g.y));
                        v1[0] *= sigm(bflo(g.z)); v1[1] *= sigm(bfhi(g.z)); v1[2] *= sigm(bflo(g.w)); v1[3] *= sigm(bfhi(g.w)); }
                    if (MODE == 2) { const u32x4 p = *(const u32x4*)(O + o);
                        v0[0] += bflo(p.x); v0[1] += bfhi(p.x); v0[2] += bflo(p.y); v0[3] += bfhi(p.y);
                        v1[0] += bflo(p.z); v1[1] += bfhi(p.z); v1[2] += bflo(p.w); v1[3] += bfhi(p.w); }
                    if (MODE == 3) {
#pragma unroll
                        for (int j = 0; j < 4; ++j) { const float a = fmaxf(v0[j], 0.f), b = fmaxf(v1[j], 0.f); v0[j] = a * a; v1[j] = b * b; } }
                    u32x4 w; w.x = cvt_pk_bf16(v0[0], v0[1]); w.y = cvt_pk_bf16(v0[2], v0[3]); w.z = cvt_pk_bf16(v1[0], v1[1]); w.w = cvt_pk_bf16(v1[2], v1[3]);
                    *(u32x4*)(O + o) = w; } }
    }
};
struct EpiSplit {
    static constexpr bool PERM = true, AFTER_DRAIN = false;
    bf16_t* MQK; bf16_t* MV; bf16_t* GM; bf16_t* GA;
    __device__ __forceinline__ void operator()(const f32x4 (&acc)[2][2][4][2], const Unit& u, int wr, int wc, int fr, int fq) const {
        bf16_t* base; int ldc, colt; const int pn = u.pn;
        if (pn < 8) { base = MQK; ldc = 2048; colt = pn * 256; }
        else if (pn < 28) { const int t = (pn - 8) >> 2; base = MV + (size_t)t * ((size_t)16384 * 1024); ldc = 1024; colt = ((pn - 8) & 3) * 256; }
        else if (pn < 36) { base = GM; ldc = 2048; colt = (pn - 28) * 256; }
        else { base = GA; ldc = 2048; colt = (pn - 36) * 256; }
        const int row0 = u.pm * BM + wr * 64 + fr, col0 = colt + wc * 32 + 8 * fq;
#pragma unroll
        for (int ai = 0; ai < 2; ++ai)
#pragma unroll
            for (int m = 0; m < 4; ++m) { bf16_t* rowp = base + (size_t)(row0 + ai * HALF + m * 16) * ldc + col0;
#pragma unroll
                for (int bj = 0; bj < 2; ++bj) { const f32x4 v0 = acc[ai][bj][m][0], v1 = acc[ai][bj][m][1];
                    u32x4 w; w.x = cvt_pk_bf16(v0[0], v0[1]); w.y = cvt_pk_bf16(v0[2], v0[3]); w.z = cvt_pk_bf16(v1[0], v1[1]); w.w = cvt_pk_bf16(v1[2], v1[3]);
                    *(u32x4*)(rowp + bj * HALF) = w; } }
    }
};

template <class Epi, class Sched, bool STAMP = false>
__device__ __forceinline__ void gemm_phase(PG8_LAS unsigned char* lds, const Gemm g, const Sched& S, const Epi& E, unsigned long long* stamps) {
    const int tid = threadIdx.x, wid = __builtin_amdgcn_readfirstlane(tid >> 6), lane = tid & 63, wr = wid >> 2, wc = wid & 3, fr = lane & 15, fq = lane >> 4;
    const int K = g.K, nt = K / BK;
    int ts_lo = 0, ts_hi = 0, nts = 0; const unsigned long long rt_entry = STAMP ? (unsigned long long)wall_clock64() : 0ull;
#define PG8_STAMP() do { if (STAMP && wid == 0 && nts < 64) { const unsigned long long _c = (unsigned long long)clock64(); \
        ts_lo = (lane == nts) ? (int)(unsigned)_c : ts_lo; ts_hi = (lane == nts) ? (int)(unsigned)(_c >> 32) : ts_hi; ++nts; } } while (0)
    PG8_STAMP();
    unsigned voffA[2], voffB[2];
#pragma unroll
    for (int i = 0; i < 2; ++i) { int R, C; stage_rc(tid * 16 + i * 8192, R, C); const int Rb = Epi::PERM ? ((R & ~31) + perm32(R & 31)) : R;
        voffA[i] = (unsigned)(R * K + C) * 2u; voffB[i] = (unsigned)(Rb * K + C) * 2u; }
    const size_t kstep = (size_t)(BK * 2);
    const size_t hstep = (size_t)HALF * K * 2;
    const size_t tstep = 2 * hstep;
    const unsigned ldsw = (unsigned)wid * 1024u;
    const int aoff = lds_byte(wr * 64 + fr, fq * 8), boff = lds_byte(wc * 32 + fr, fq * 8);
#define PG8_SA(b, h) (((b) * 2 + (h)) * HTB)
#define PG8_SB(b, h) ((4 + (b) * 2 + (h)) * HTB)
#define PG8_STAGE(bufoff, gbase, voff) do { _Pragma("unroll") for (int _i = 0; _i < 2; ++_i) \
        __builtin_amdgcn_global_load_lds((const unsigned*)((const char*)(gbase) + (voff)[_i]), (PG8_LAS unsigned*)(lds + (bufoff) + ldsw + _i * 8192), 16, 0, 0); } while (0)
#define PG8_LDA(dst, b, h) do { _Pragma("unroll") for (int m = 0; m < 4; ++m) _Pragma("unroll") for (int k = 0; k < 2; ++k) dst[m][k] = *(const PG8_LAS bf16x8*)(lds + PG8_SA(b, h) + aoff + m * 2048 + k * 1024); } while (0)
#define PG8_LDB(dst, b, h) do { _Pragma("unroll") for (int n = 0; n < 2; ++n) _Pragma("unroll") for (int k = 0; k < 2; ++k) dst[n][k] = *(const PG8_LAS bf16x8*)(lds + PG8_SB(b, h) + boff + n * 2048 + k * 1024); } while (0)
#define PG8_MMA(ai, bj, At, Bt) do { __builtin_amdgcn_s_setprio(1); _Pragma("unroll") for (int m = 0; m < 4; ++m) _Pragma("unroll") for (int n = 0; n < 2; ++n) _Pragma("unroll") for (int k = 0; k < 2; ++k) \
        acc[ai][bj][m][n] = __builtin_amdgcn_mfma_f32_16x16x32_bf16(Bt[n][k], At[m][k], acc[ai][bj][m][n], 0, 0, 0); __builtin_amdgcn_s_setprio(0); } while (0)
#define PG8_WAIT_V(n) asm volatile("s_waitcnt vmcnt(" #n ")" ::: "memory")
#define PG8_WAIT_L(n) asm volatile("s_waitcnt lgkmcnt(" #n ")" ::: "memory")
#define PG8_BAR __builtin_amdgcn_s_barrier()
#define PG8_SCHED __builtin_amdgcn_sched_barrier(0)
    Unit cur, nxt; int ui = 0;
    if (!S.next(0, cur)) return;
    f32x4 acc[2][2][4][2];
#pragma unroll
    for (int a = 0; a < 2; ++a)
#pragma unroll
        for (int b = 0; b < 2; ++b)
#pragma unroll
            for (int m = 0; m < 4; ++m)
#pragma unroll
                for (int n = 0; n < 2; ++n) acc[a][b][m][n] = (f32x4){0.f, 0.f, 0.f, 0.f};
    bf16x8 At[4][2], B0[2][2], B1[2][2];
    const char* cA = (const char*)g.A + (size_t)cur.pm * tstep; const char* cB = (const char*)g.Bt + (size_t)cur.pn * tstep;
    S.a_ready(cur);
    PG8_STAGE(PG8_SB(0, 0), cB, voffB); PG8_STAGE(PG8_SA(0, 0), cA, voffA); PG8_STAGE(PG8_SB(0, 1), cB + hstep, voffB); PG8_STAGE(PG8_SA(0, 1), cA + hstep, voffA);
    if (wr == 1) PG8_BAR;
    PG8_WAIT_V(4); PG8_BAR;
    PG8_STAGE(PG8_SB(1, 0), cB + kstep, voffB); PG8_STAGE(PG8_SA(1, 0), cA + kstep, voffA); PG8_STAGE(PG8_SB(1, 1), cB + hstep + kstep, voffB);
    PG8_WAIT_V(6); PG8_BAR;
    PG8_STAMP();
    for (;;) {
        const bool has_next = S.next(ui + 1, nxt);
        const char* nA = has_next ? (const char*)g.A + (size_t)nxt.pm * tstep : cA; const char* nB = has_next ? (const char*)g.Bt + (size_t)nxt.pn * tstep : cB;
        for (int t = 0; t < nt; t += 2) {
            const bool last = (t == nt - 2);
            const char* a1 = cA + (size_t)(t + 1) * kstep;
            const char* a2 = last ? nA : cA + (size_t)(t + 2) * kstep; const char* b2 = last ? nB : cB + (size_t)(t + 2) * kstep;
            const char* a3 = a2 + kstep; const char* b3 = b2 + kstep;
            if (last && has_next) S.a_ready(nxt);
            PG8_LDB(B0, 0, 0); PG8_SCHED; PG8_LDA(At, 0, 0); PG8_STAGE(PG8_SA(1, 1), a1 + hstep, voffA);
            PG8_WAIT_L(8); PG8_BAR; PG8_WAIT_L(0); PG8_MMA(0, 0, At, B0); PG8_BAR; PG8_SCHED;
            PG8_LDB(B1, 0, 1); PG8_STAGE(PG8_SB(0, 0), b2, voffB);
            PG8_BAR; PG8_WAIT_L(0); PG8_MMA(0, 1, At, B1); PG8_BAR;
            PG8_LDA(At, 0, 1); PG8_STAGE(PG8_SA(0, 0), a2, voffA);
            PG8_BAR; PG8_WAIT_L(0); PG8_MMA(1, 0, At, B0); PG8_BAR; PG8_SCHED;
            PG8_STAGE(PG8_SB(0, 1), b2 + hstep, voffB);
            PG8_WAIT_V(6); PG8_BAR; PG8_MMA(1, 1, At, B1); PG8_BAR;
            PG8_LDB(B0, 1, 0); PG8_SCHED; PG8_LDA(At, 1, 0); PG8_STAGE(PG8_SA(0, 1), a2 + hstep, voffA);
            PG8_WAIT_L(8); PG8_BAR; PG8_WAIT_L(0); PG8_MMA(0, 0, At, B0); PG8_BAR; PG8_SCHED;
            PG8_LDB(B1, 1, 1); PG8_STAGE(PG8_SB(1, 0), b3, voffB);
            PG8_BAR; PG8_WAIT_L(0); PG8_MMA(0, 1, At, B1); PG8_BAR;
            PG8_LDA(At, 1, 1); PG8_STAGE(PG8_SA(1, 0), a3, voffA);
            PG8_BAR; PG8_WAIT_L(0); PG8_MMA(1, 0, At, B0); PG8_BAR; PG8_SCHED;
            PG8_STAGE(PG8_SB(1, 1), b3 + hstep, voffB);
            PG8_WAIT_V(6); PG8_BAR; PG8_MMA(1, 1, At, B1); PG8_BAR;
        }
        PG8_STAMP();
        if constexpr (!Epi::AFTER_DRAIN) { E(acc, cur, wr, wc, fr, fq); S.done(cur); }
        PG8_STAMP();
        if (!has_next) break;
#pragma unroll
        for (int a = 0; a < 2; ++a)
#pragma unroll
            for (int b = 0; b < 2; ++b)
#pragma unroll
                for (int m = 0; m < 4; ++m)
#pragma unroll
                    for (int n = 0; n < 2; ++n) acc[a][b][m][n] = (f32x4){0.f, 0.f, 0.f, 0.f};
        cur = nxt; cA = nA; cB = nB; ++ui;
    }
    PG8_WAIT_V(0);
    if (wr == 0) PG8_BAR;
    PG8_BAR;
    if constexpr (Epi::AFTER_DRAIN) { E.fused(acc, cur, wr, wc, fr, fq, lds, wid, lane); S.done(cur); }
    PG8_STAMP();
    if (STAMP && wid == 0) { stamps[lane] = lane < nts ? (((unsigned long long)(unsigned)ts_hi << 32) | (unsigned)ts_lo) : 0ull;
        if (lane == 62) stamps[62] = rt_entry; if (lane == 63) stamps[63] = (unsigned long long)wall_clock64(); }
#undef PG8_STAMP
#undef PG8_SA
#undef PG8_SB
#undef PG8_STAGE
#undef PG8_LDA
#undef PG8_LDB
#undef PG8_MMA
#undef PG8_WAIT_V
#undef PG8_WAIT_L
#undef PG8_BAR
#undef PG8_SCHED
}
}

typedef unsigned short bf16;
typedef short bf16x8 __attribute__((ext_vector_type(8)));
typedef float f32x4 __attribute__((ext_vector_type(4)));
constexpr int SEQ = 16384, DM = 2048, INC = 11272, NPROJ = 11264, DFF = 8192;
constexpr float EPS = 1e-6f;
constexpr size_t MiB = (size_t)1 << 20;
constexpr size_t WS_IFP = 0;
constexpr size_t WS_KMEAN = 512 * 1024;
constexpr size_t WS_CNT = 768 * 1024;
constexpr size_t WS_FCH = 4 * MiB;
constexpr size_t WS_MLOC = 4 * MiB + 64 * 1024;
constexpr size_t WS_MPREV = 904 * 1024;
constexpr size_t WS_BAR = 960 * 1024;
constexpr size_t WS_NST = 1 * MiB;
constexpr size_t WS_NPREV = 1536 * 1024;
constexpr size_t WS_LSE = 2 * MiB;
constexpr size_t WS_WUP = 8 * MiB, WS_WDOWN = 40 * MiB, WS_WIN = 72 * MiB, WS_WBM = 116 * MiB, WS_WBA = 120 * MiB, WS_WOUT = 124 * MiB;
constexpr size_t WS_MQK = 132 * MiB;
constexpr size_t WS_MV = 196 * MiB, WS_MO = 228 * MiB, WS_AQ = 260 * MiB, WS_AK = 292 * MiB, WS_AV = 324 * MiB;
constexpr size_t WS_GM = 356 * MiB;
constexpr size_t WS_GA = 420 * MiB;
constexpr size_t WS_LIST = 484 * MiB;
constexpr size_t WS_U = 132 * MiB;
constexpr size_t WS_NEED = 500 * MiB;
constexpr int LDS_BYTES = 159744;

__device__ __forceinline__ float bf2f(unsigned short b) { return __uint_as_float(((unsigned)b) << 16); }
__device__ __forceinline__ unsigned short f2bf(float f) { unsigned u = __float_as_uint(f); u += 0x7fffu + ((u >> 16) & 1u); return (unsigned short)(u >> 16); }
__device__ __forceinline__ unsigned pk2(float lo, float hi) { return (unsigned)f2bf(lo) | ((unsigned)f2bf(hi) << 16); }
__device__ __forceinline__ float lo16(unsigned w) { return __uint_as_float(w << 16); }
__device__ __forceinline__ float hi16(unsigned w) { return __uint_as_float(w & 0xffff0000u); }
__device__ __forceinline__ float sigmoidf_(float x) { return 1.0f / (1.0f + __expf(-x)); }
__device__ __forceinline__ float logsigf_(float x) { return fminf(x, 0.f) - log1pf(expf(-fabsf(x))); }
__device__ __forceinline__ float wave_sum(float v) {
#pragma unroll
    for (int o = 1; o < 64; o <<= 1) v += __shfl_xor(v, o);
    return v; }
__device__ __forceinline__ float wave_max(float v) {
#pragma unroll
    for (int o = 1; o < 64; o <<= 1) v = fmaxf(v, __shfl_xor(v, o));
    return v; }
__device__ __forceinline__ float wave_incl_sum(float v, int lane) {
#pragma unroll
    for (int o = 1; o < 64; o <<= 1) { const float t = __shfl_up(v, o); if (lane >= o) v += t; }
    return v; }
__device__ __forceinline__ float wave_incl_max(float v, int lane) {
#pragma unroll
    for (int o = 1; o < 64; o <<= 1) { const float t = __shfl_up(v, o); if (lane >= o) v = fmaxf(v, t); }
    return v; }
__device__ __forceinline__ int wave_incl_sum_i(int v, int lane) {
#pragma unroll
    for (int o = 1; o < 64; o <<= 1) { const int t = __shfl_up(v, o); if (lane >= o) v += t; }
    return v; }
__device__ __forceinline__ f32x4 mma16(bf16x8 a, bf16x8 b, f32x4 c) { return __builtin_amdgcn_mfma_f32_16x16x32_bf16(a, b, c, 0, 0, 0); }
__device__ __forceinline__ void unpack8(const uint4 v, float (&f)[8]) { f[0] = lo16(v.x); f[1] = hi16(v.x); f[2] = lo16(v.y); f[3] = hi16(v.y); f[4] = lo16(v.z); f[5] = hi16(v.z); f[6] = lo16(v.w); f[7] = hi16(v.w); }
__device__ __forceinline__ uint4 pack8(const float (&f)[8]) { uint4 v; v.x = pk2(f[0], f[1]); v.y = pk2(f[2], f[3]); v.z = pk2(f[4], f[5]); v.w = pk2(f[6], f[7]); return v; }

struct Args { const void* in[17]; float* out; unsigned char* ws; int ph_lo, ph_hi; };
struct Ctx {
    unsigned char* lds; int tid, lane, wave, G, bid;
    const Args& a;
    float* out; unsigned char* ws;
};

__device__ __forceinline__ void p0_transpose_item(const float* W, int K, int ldw, int nblk, bool gap, bf16* WT, float* scr, int item, int lane) {
    const int kb = item / nblk, nb = item % nblk, k0 = 64 * kb, n0 = 32 * nb, n0s = n0 + ((gap && n0 >= 4096) ? 8 : 0);
    float wv[32];
#pragma unroll
    for (int i = 0; i < 32; ++i) wv[i] = W[(size_t)(k0 + 2 * i + (lane >> 5)) * ldw + n0s + (lane & 31)];
#pragma unroll
    for (int i = 0; i < 32; ++i) scr[(2 * i + (lane >> 5)) * 33 + (lane & 31)] = wv[i];
    __builtin_amdgcn_s_waitcnt(0xc07f); asm volatile("" ::: "memory");
    const int c = lane & 7;
#pragma unroll
    for (int j = 0; j < 4; ++j) { const int n = (lane >> 3) + 8 * j; const float* s = scr + (8 * c) * 33 + n;
        uint4 o; o.x = pk2(s[0 * 33], s[1 * 33]); o.y = pk2(s[2 * 33], s[3 * 33]); o.z = pk2(s[4 * 33], s[5 * 33]); o.w = pk2(s[6 * 33], s[7 * 33]);
        *(uint4*)(WT + (size_t)(n0 + n) * K + k0 + 8 * c) = o; }
    __builtin_amdgcn_s_waitcnt(0xc07f); asm volatile("" ::: "memory");
}
__device__ __forceinline__ void wg_transpose_item(const float* W, int K, int ldw, int nblk, bool gap, bf16* WT, float* tile, int item, int tid) {
    const int kb = item / nblk, nb = item % nblk, k0 = 64 * kb, n0 = 256 * nb, n0s = n0 + ((gap && n0 >= 4096) ? 8 : 0);
    float4 v[8];
#pragma unroll
    for (int i = 0; i < 8; ++i) { const int idx = tid + i * 512, row = idx >> 6, c4 = idx & 63; v[i] = *(const float4*)(W + (size_t)(k0 + row) * ldw + n0s + 4 * c4); }
    __syncthreads();
#pragma unroll
    for (int i = 0; i < 8; ++i) { const int idx = tid + i * 512, row = idx >> 6, c4 = idx & 63; float* t = tile + row * 257 + 4 * c4; t[0] = v[i].x; t[1] = v[i].y; t[2] = v[i].z; t[3] = v[i].w; }
    __syncthreads();
    const int c = tid & 7;
#pragma unroll
    for (int p = 0; p < 4; ++p) { const int n = p * 64 + (tid >> 3); const float* s = tile + (8 * c) * 257 + n;
        uint4 o; o.x = pk2(s[0 * 257], s[1 * 257]); o.y = pk2(s[2 * 257], s[3 * 257]); o.z = pk2(s[4 * 257], s[5 * 257]); o.w = pk2(s[6 * 257], s[7 * 257]);
        *(uint4*)(WT + (size_t)(n0 + n) * K + k0 + 8 * c) = o; }
}
__device__ __forceinline__ int wif_off(int k) { return k * 8 + (k >> 2) * 4; }
__device__ __forceinline__ void phase0(Ctx& C) {
    float* WIF = (float*)C.lds;
    for (int idx = C.tid; idx < 2048 * 8; idx += 512) { const int k = idx >> 3, j = idx & 7; WIF[wif_off(k) + j] = ((const float*)C.a.in[3])[(size_t)k * INC + 4096 + j]; }
    __syncthreads();
    const int gw = C.bid * 8 + C.wave, NGW = C.G * 8, lane = C.lane;
    bf16* XN = (bf16*)C.out; float* IFP = (float*)(C.ws + WS_IFP);
    for (int row = gw; row < SEQ; row += NGW) {
        const float4* xr = (const float4*)(((const float*)C.a.in[0]) + (size_t)row * DM) + lane; float ss = 0.f; float4 v[8], nw[8];
#pragma unroll
        for (int j = 0; j < 8; ++j) { v[j] = xr[64 * j]; nw[j] = *(const float4*)(((const float*)C.a.in[2]) + 256 * j + 4 * lane); }
#pragma unroll
        for (int j = 0; j < 8; ++j) ss += (v[j].x * v[j].x + v[j].y * v[j].y) + (v[j].z * v[j].z + v[j].w * v[j].w);
        const float rstd = rsqrtf(wave_sum(ss) * (1.f / DM) + EPS);
        float a8[8];
#pragma unroll
        for (int i = 0; i < 8; ++i) a8[i] = 0.f;
#pragma unroll
        for (int j = 0; j < 8; ++j) { const int k = 256 * j + 4 * lane;
            float xn[4] = {v[j].x * rstd * nw[j].x, v[j].y * rstd * nw[j].y, v[j].z * rstd * nw[j].z, v[j].w * rstd * nw[j].w};
            uint2 o; o.x = pk2(xn[0], xn[1]); o.y = pk2(xn[2], xn[3]); *(uint2*)(XN + (size_t)row * DM + k) = o;
#pragma unroll
            for (int e = 0; e < 4; ++e) { const float4* wf = (const float4*)(WIF + wif_off(k + e)); const float4 w0 = wf[0], w1 = wf[1];
                a8[0] += xn[e] * w0.x; a8[1] += xn[e] * w0.y; a8[2] += xn[e] * w0.z; a8[3] += xn[e] * w0.w; a8[4] += xn[e] * w1.x; a8[5] += xn[e] * w1.y; a8[6] += xn[e] * w1.z; a8[7] += xn[e] * w1.w; }
            asm volatile("" ::: "memory"); }
#pragma unroll
        for (int i = 0; i < 8; ++i) a8[i] = wave_sum(a8[i]);
        if (lane == 0) { float4* o = (float4*)(IFP + (size_t)row * 8); o[0] = make_float4(a8[0], a8[1], a8[2], a8[3]); o[1] = make_float4(a8[4], a8[5], a8[6], a8[7]); }
    }
    __syncthreads();
    float* tile = (float*)C.lds;
    constexpr int J_IN = 32 * 44, J_BM = 16 * 8, J_OUT = 32 * 8, NJT = J_IN + 2 * J_BM + J_OUT;
    for (int it = C.bid; it < NJT; it += C.G) { int r = it;
        if (r < J_IN) { wg_transpose_item(((const float*)C.a.in[3]), DM, INC, 44, true, (bf16*)(C.ws + WS_WIN), tile, r, C.tid); continue; } r -= J_IN;
        if (r < J_BM) { wg_transpose_item(((const float*)C.a.in[9]), 1024, DM, 8, false, (bf16*)(C.ws + WS_WBM), tile, r, C.tid); continue; } r -= J_BM;
        if (r < J_BM) { wg_transpose_item(((const float*)C.a.in[10]), 1024, DM, 8, false, (bf16*)(C.ws + WS_WBA), tile, r, C.tid); continue; } r -= J_BM;
        wg_transpose_item(((const float*)C.a.in[11]), DM, DM, 8, false, (bf16*)(C.ws + WS_WOUT), tile, r, C.tid); }
    __syncthreads();
}

__device__ __forceinline__ void convert_ffn_weights(Ctx& C, int first_wg) {
    if (C.bid < first_wg) return;
    float* tile = (float*)C.lds;
    constexpr int J_UP = 32 * 32, J_DOWN = 128 * 8;
    for (int it = C.bid - first_wg; it < J_UP + J_DOWN; it += C.G - first_wg) {
        if (it < J_UP) wg_transpose_item(((const float*)C.a.in[14]), DM, DFF, 32, false, (bf16*)(C.ws + WS_WUP), tile, it, C.tid);
        else wg_transpose_item(((const float*)C.a.in[15]), DFF, DM, 8, false, (bf16*)(C.ws + WS_WDOWN), tile, it - J_UP, C.tid); }
}
__device__ __forceinline__ void phase2(Ctx& C) {
    const bf16* MQK = (const bf16*)(C.ws + WS_MQK); bf16* QKC = (bf16*)C.out;
    const int tid = C.tid;
    for (int item = C.bid; item < SEQ / 64; item += C.G) {
        const int half = tid >> 8, cg8 = (tid & 255) * 8, t0 = item * 64 + half * 32;
        float w[4][8], b[8];
#pragma unroll
        for (int j = 0; j < 4; ++j) { const float4 a = *(const float4*)(((const float*)C.a.in[4]) + j * 2048 + cg8), bb = *(const float4*)(((const float*)C.a.in[4]) + j * 2048 + cg8 + 4);
            w[j][0] = a.x; w[j][1] = a.y; w[j][2] = a.z; w[j][3] = a.w; w[j][4] = bb.x; w[j][5] = bb.y; w[j][6] = bb.z; w[j][7] = bb.w; }
        { const float4 a = *(const float4*)(((const float*)C.a.in[5]) + cg8), bb = *(const float4*)(((const float*)C.a.in[5]) + cg8 + 4); b[0] = a.x; b[1] = a.y; b[2] = a.z; b[3] = a.w; b[4] = bb.x; b[5] = bb.y; b[6] = bb.z; b[7] = bb.w; }
        float r0[8], r1[8], r2[8], cur[8];
#pragma unroll
        for (int i = 0; i < 8; ++i) { r0[i] = 0.f; r1[i] = 0.f; r2[i] = 0.f; }
        if (t0 >= 3) { unpack8(*(const uint4*)(MQK + (size_t)(t0 - 3) * 2048 + cg8), r0); unpack8(*(const uint4*)(MQK + (size_t)(t0 - 2) * 2048 + cg8), r1); unpack8(*(const uint4*)(MQK + (size_t)(t0 - 1) * 2048 + cg8), r2); }
        const float sc = (cg8 >= 1024) ? 0.0625f : 1.0f;
#pragma unroll 4
        for (int t = t0; t < t0 + 32; ++t) {
            unpack8(*(const uint4*)(MQK + (size_t)t * 2048 + cg8), cur);
            float o[8];
#pragma unroll
            for (int i = 0; i < 8; ++i) { const float y = b[i] + w[0][i] * r0[i] + w[1][i] * r1[i] + w[2][i] * r2[i] + w[3][i] * cur[i]; o[i] = y * sigmoidf_(y) * sc; r0[i] = r1[i]; r1[i] = r2[i]; r2[i] = cur[i]; }
            *(uint4*)(QKC + (size_t)t * 2048 + cg8) = pack8(o);
        }
    }
    bf16* AQ = (bf16*)(C.ws + WS_AQ); bf16* AK = (bf16*)(C.ws + WS_AK); float* KMEAN = (float*)(C.ws + WS_KMEAN);
    float* red = (float*)C.lds;
    const int tp = tid >> 3, dg = tid & 7;
    float invf[8];
#pragma unroll
    for (int i = 0; i < 8; ++i) invf[i] = 1.0f / powf(10000.0f, (float)(2 * (dg * 8 + i)) / 128.0f);
    for (int item = C.bid; item < 512; item += C.G) {
        const int h = item >> 6, n = item & 63;
        float ks1[8], ks2[8];
#pragma unroll
        for (int i = 0; i < 8; ++i) { ks1[i] = 0.f; ks2[i] = 0.f; }
        for (int pass = 0; pass < 4; ++pass) {
            const int t = n * 256 + pass * 64 + tp; const float p = (float)((const int*)C.a.in[1])[t];
            float cs[8], sn[8];
#pragma unroll
            for (int i = 0; i < 8; ++i) { const float ang = p * invf[i]; const double rev = (double)ang * 0.15915494309189535; const float fr = (float)(rev - rint(rev)); sn[i] = __builtin_amdgcn_sinf(fr); cs[i] = __builtin_amdgcn_cosf(fr); }
            const size_t o1 = (size_t)t * 1024 + h * 128 + dg * 8, o2 = o1 + 64;
            float x1[8], x2[8], y1[8], y2[8];
            unpack8(*(const uint4*)(AQ + o1), x1); unpack8(*(const uint4*)(AQ + o2), x2);
#pragma unroll
            for (int i = 0; i < 8; ++i) { y1[i] = x1[i] * cs[i] - x2[i] * sn[i]; y2[i] = x2[i] * cs[i] + x1[i] * sn[i]; }
            *(uint4*)(AQ + o1) = pack8(y1); *(uint4*)(AQ + o2) = pack8(y2);
            unpack8(*(const uint4*)(AK + o1), x1); unpack8(*(const uint4*)(AK + o2), x2);
#pragma unroll
            for (int i = 0; i < 8; ++i) { y1[i] = x1[i] * cs[i] - x2[i] * sn[i]; y2[i] = x2[i] * cs[i] + x1[i] * sn[i]; ks1[i] += y1[i]; ks2[i] += y2[i]; }
            *(uint4*)(AK + o1) = pack8(y1); *(uint4*)(AK + o2) = pack8(y2);
        }
        __syncthreads();
#pragma unroll
        for (int i = 0; i < 8; ++i) { red[tp * 128 + dg * 8 + i] = ks1[i]; red[tp * 128 + 64 + dg * 8 + i] = ks2[i]; }
        __syncthreads();
        if (tid < 128) { float s = 0.f; for (int r = 0; r < 64; ++r) s += red[r * 128 + tid]; KMEAN[(size_t)item * 128 + tid] = s * (1.0f / 256.0f); }
    }
    __syncthreads();
}

__device__ __forceinline__ void gate_scalars(const Ctx& C, int c, int h, int lane, float& b0, float& b1, float& li0, float& li1) {
    const float* IFP = (const float*)(C.ws + WS_IFP);
    const float fb = ((const float*)C.a.in[7])[h], ib = ((const float*)C.a.in[6])[h];
    const float f0 = IFP[(size_t)(c * 128 + lane) * 8 + 4 + h] + fb, f1 = IFP[(size_t)(c * 128 + 64 + lane) * 8 + 4 + h] + fb;
    li0 = IFP[(size_t)(c * 128 + lane) * 8 + h] + ib; li1 = IFP[(size_t)(c * 128 + 64 + lane) * 8 + h] + ib;
    b0 = wave_incl_sum(logsigf_(f0), lane); const float tot0 = __shfl(b0, 63); b1 = wave_incl_sum(logsigf_(f1), lane) + tot0;
}
__device__ __forceinline__ void load_transposed_256(const bf16* src, int ld, bf16* Tt, const float* ev, int tid) {
    const int l = tid & 127, cgp = tid >> 7; const float el = ev ? ev[l] : 1.0f;
    const bf16* row = src + (size_t)l * ld;
#pragma unroll
    for (int i = 0; i < 8; ++i) { const int g = cgp * 8 + i; float f[8]; unpack8(*(const uint4*)(row + g * 8), f);
#pragma unroll
        for (int j = 0; j < 8; ++j) Tt[(g * 8 + j) * 136 + l] = f2bf(f[j] * el); }
}
__device__ __forceinline__ void mlstm_local_item(Ctx& C, int item) {
    const int c = item >> 2, h = item & 3, tid = C.tid, lane = C.lane, wave = C.wave, g = lane >> 4, tq = lane & 15;
    bf16* Vt = (bf16*)C.lds; bf16* Kt = Vt + 256 * 136; float* ev = (float*)(C.lds + 139264);
    const bf16* QKC = (const bf16*)C.out; bf16* CST = (bf16*)((unsigned char*)C.out + 64 * MiB); const bf16* MV = (const bf16*)(C.ws + WS_MV);
    if (wave == 0) {
        float b0, b1, li0, li1; gate_scalars(C, c, h, lane, b0, b1, li0, li1);
        const float F = __shfl(b1, 63); const float w0 = F - b0 + li0, w1 = F - b1 + li1; const float ml = wave_max(fmaxf(w0, w1));
        ev[lane] = expf(w0 - ml); ev[lane + 64] = expf(w1 - ml);
        if (lane == 0) { ((float*)(C.ws + WS_FCH))[item * 32] = F; ((float*)(C.ws + WS_MLOC))[item * 32] = ml; }
    }
    __syncthreads();
    load_transposed_256(MV + (size_t)(c * 128) * 1024 + h * 256, 1024, Vt, ev, tid);
    load_transposed_256(QKC + (size_t)(c * 128) * 2048 + 1024 + h * 256, 2048, Kt, nullptr, tid);
    __syncthreads();
#pragma unroll 1
    for (int nh = 0; nh < 2; ++nh) {
        f32x4 acc[2][8];
#pragma unroll
        for (int mi = 0; mi < 2; ++mi)
#pragma unroll
            for (int ni = 0; ni < 8; ++ni) acc[mi][ni] = (f32x4){0.f, 0.f, 0.f, 0.f};
#pragma unroll
        for (int ks = 0; ks < 4; ++ks) {
            bf16x8 a[2];
#pragma unroll
            for (int mi = 0; mi < 2; ++mi) a[mi] = *(const bf16x8*)(Kt + (32 * wave + mi * 16 + tq) * 136 + ks * 32 + 8 * g);
#pragma unroll
            for (int ni = 0; ni < 8; ++ni) { const bf16x8 b = *(const bf16x8*)(Vt + ((nh * 8 + ni) * 16 + tq) * 136 + ks * 32 + 8 * g);
#pragma unroll
                for (int mi = 0; mi < 2; ++mi) acc[mi][ni] = mma16(a[mi], b, acc[mi][ni]); }
        }
#pragma unroll
        for (int mi = 0; mi < 2; ++mi)
#pragma unroll
            for (int ni = 0; ni < 8; ++ni) { uint2 o; o.x = pk2(acc[mi][ni][0], acc[mi][ni][1]); o.y = pk2(acc[mi][ni][2], acc[mi][ni][3]);
                *(uint2*)(CST + ((size_t)item * 256 + (nh * 8 + ni) * 16 + tq) * 256 + 32 * wave + mi * 16 + 4 * g) = o; }
    }
    if (tid < 256) { float s = 0.f; const bf16* kr = Kt + tid * 136;
        for (int l8 = 0; l8 < 16; ++l8) { float f[8]; unpack8(*(const uint4*)(kr + l8 * 8), f);
#pragma unroll
            for (int j = 0; j < 8; ++j) s += f[j] * ev[l8 * 8 + j]; }
        ((float*)(C.ws + WS_NST))[(size_t)item * 256 + tid] = s; }
    __syncthreads();
}
__device__ __forceinline__ void mlstm_scan(Ctx& C) {
    const float* FCH = (const float*)(C.ws + WS_FCH); const float* MLOC = (const float*)(C.ws + WS_MLOC); float* MPREV = (float*)(C.ws + WS_MPREV);
    const bf16* CST = (const bf16*)((unsigned char*)C.out + 64 * MiB); const float* NST = (const float*)(C.ws + WS_NST); bf16* CPV = (bf16*)(C.ws + WS_MQK); float* NPV = (float*)(C.ws + WS_NPREV);
    for (int item = C.bid; item < 129; item += C.G) {
        if (item < 128) {
            const int e = item * 512 + C.tid, h = e >> 14, off = (e & 16383) * 4;
            float st[4] = {0.f, 0.f, 0.f, 0.f}; float m = 0.f;
            const bf16* p = CST + (size_t)h * 65536 + off; bf16* pw = CPV + (size_t)h * 65536 + off;
#pragma unroll 1
            for (int c0 = 0; c0 < 128; c0 += 32) {
                uint2 ld[32]; float Fb[32], Mb[32];
#pragma unroll
                for (int j = 0; j < 32; ++j) { ld[j] = *(const uint2*)(p + (size_t)(c0 + j) * 4 * 65536); Fb[j] = FCH[((c0 + j) * 4 + h) * 32]; Mb[j] = MLOC[((c0 + j) * 4 + h) * 32]; }
#pragma unroll
                for (int j = 0; j < 32; ++j) { const int c = c0 + j; const float Fc = Fb[j], ml = Mb[j];
                    uint2 o; o.x = pk2(st[0], st[1]); o.y = pk2(st[2], st[3]); *(uint2*)(pw + (size_t)c * 4 * 65536) = o;
                    const float mn = fmaxf(Fc + m, ml), a = expf(Fc + m - mn), gg = expf(ml - mn);
                    st[0] = a * st[0] + gg * lo16(ld[j].x); st[1] = a * st[1] + gg * hi16(ld[j].x); st[2] = a * st[2] + gg * lo16(ld[j].y); st[3] = a * st[3] + gg * hi16(ld[j].y); m = mn; }
            }
        } else {
#pragma unroll
            for (int rep = 0; rep < 2; ++rep) { const int el = C.tid + rep * 512, h = el >> 8; float st = 0.f, m = 0.f;
                for (int c = 0; c < 128; ++c) { const float Fc = FCH[(c * 4 + h) * 32], ml = MLOC[(c * 4 + h) * 32]; const size_t qi = (size_t)(c * 4 + h) * 256 + (el & 255); const float nl = NST[qi]; NPV[qi] = st;
                    if ((el & 255) == 0) MPREV[c * 4 + h] = m;
                    const float mn = fmaxf(Fc + m, ml), a = expf(Fc + m - mn), gg = expf(ml - mn); st = a * st + gg * nl; m = mn; } }
        }
    }
}
__device__ __forceinline__ void mlstm_num1_item(Ctx& C, int item) {
    const int c = item >> 2, h = item & 3, tid = C.tid, lane = C.lane, wave = C.wave, g = lane >> 4, tq = lane & 15;
    bf16* Cs = (bf16*)C.lds;
    const bf16* QKC = (const bf16*)C.out; const bf16* CPV = (const bf16*)(C.ws + WS_MQK); bf16* NUM1 = (bf16*)(C.ws + WS_WIN);
    bf16x8 qf[8];
    { const bf16* qrow = QKC + (size_t)(c * 128 + 16 * wave + tq) * 2048 + h * 256 + 8 * g;
#pragma unroll
      for (int ks = 0; ks < 8; ++ks) qf[ks] = *(const bf16x8*)(qrow + ks * 32); }
#pragma unroll 1
    for (int hv = 0; hv < 2; ++hv) {
        __syncthreads();
#pragma unroll
        for (int i = 0; i < 8; ++i) { const int idx = tid + i * 512, row = idx >> 5, ch = idx & 31;
            *(uint4*)(Cs + row * 264 + ch * 8) = *(const uint4*)(CPV + (size_t)item * 65536 + (size_t)(hv * 128 + row) * 256 + ch * 8); }
        __syncthreads();
        f32x4 o[8];
#pragma unroll
        for (int ni = 0; ni < 8; ++ni) { o[ni] = (f32x4){0.f, 0.f, 0.f, 0.f};
#pragma unroll
            for (int ks = 0; ks < 8; ++ks) { const bf16x8 cf = *(const bf16x8*)(Cs + (ni * 16 + tq) * 264 + ks * 32 + 8 * g); o[ni] = mma16(qf[ks], cf, o[ni]); } }
#pragma unroll
        for (int ni = 0; ni < 8; ++ni)
#pragma unroll
            for (int r = 0; r < 4; ++r) NUM1[(size_t)(c * 128 + 16 * wave + 4 * g + r) * 1024 + h * 256 + hv * 128 + ni * 16 + tq] = f2bf(o[ni][r]);
    }
    asm volatile("s_waitcnt vmcnt(0)" ::: "memory");
    __syncthreads();
}
__device__ __forceinline__ void mlstm_out_item(Ctx& C, int item) {
    const int c = item >> 2, h = item & 3, tid = C.tid, lane = C.lane, wave = C.wave, g = lane >> 4, tq = lane & 15;
    bf16* Ks = (bf16*)C.lds; bf16* Vt = (bf16*)(C.lds + 67584); float* sc = (float*)(C.lds + 137216); const bf16* NUM1 = (const bf16*)(C.ws + WS_WIN);
    float* negmx = sc, *lib = sc + 128, *inter = sc + 256, *emt = sc + 384, *npv = sc + 512, *dens = sc + 768;
    const bf16* QKC = (const bf16*)C.out;
#ifdef EXP_F
    const bf16* CST = (const bf16*)((unsigned char*)C.out + 64 * MiB);
#else
    const bf16* CST = (const bf16*)(C.ws + WS_MQK);
#endif
 const bf16* MV = (const bf16*)(C.ws + WS_MV); bf16* MO = (bf16*)(C.ws + WS_MO);
    if (wave == 0) {
        const float mp = ((const float*)(C.ws + WS_MPREV))[item];
        float b0, b1, li0, li1; gate_scalars(C, c, h, lane, b0, b1, li0, li1);
        const float x0 = li0 - b0, x1 = li1 - b1; const float cm0 = wave_incl_max(x0, lane); const float t0 = __shfl(cm0, 63); const float cm1 = fmaxf(wave_incl_max(x1, lane), t0);
        const float M0 = fmaxf(mp, cm0), M1 = fmaxf(mp, cm1);
        negmx[lane] = -M0; negmx[lane + 64] = -M1; lib[lane] = x0; lib[lane + 64] = x1; inter[lane] = expf(mp - M0); inter[lane + 64] = expf(mp - M1);
        emt[lane] = expf(-(b0 + M0)); emt[lane + 64] = expf(-(b1 + M1));
    }
    if (tid < 256) npv[tid] = ((const float*)(C.ws + WS_NPREV))[(size_t)item * 256 + tid];
#pragma unroll
    for (int i = 0; i < 8; ++i) { const int idx = tid + i * 512, row = idx >> 5, ch = idx & 31;
        *(uint4*)(Ks + row * 264 + ch * 8) = *(const uint4*)(QKC + (size_t)(c * 128 + row) * 2048 + 1024 + h * 256 + ch * 8); }
    load_transposed_256(MV + (size_t)(c * 128) * 1024 + h * 256, 1024, Vt, nullptr, tid);
    __syncthreads();
    const int t = 16 * wave + tq;
    bf16x8 qf[8];
    { const bf16* qrow = QKC + (size_t)(c * 128 + t) * 2048 + h * 256 + 8 * g;
#pragma unroll
      for (int ks = 0; ks < 8; ++ks) qf[ks] = *(const bf16x8*)(qrow + ks * 32); }
    f32x4 sacc[8];
#pragma unroll
    for (int mi = 0; mi < 8; ++mi) sacc[mi] = (f32x4){0.f, 0.f, 0.f, 0.f};
#pragma unroll
    for (int mi = 0; mi < 8; ++mi) if (mi <= wave) {
#pragma unroll
        for (int ks = 0; ks < 8; ++ks) { const bf16x8 a = *(const bf16x8*)(Ks + (mi * 16 + tq) * 264 + ks * 32 + 8 * g); sacc[mi] = mma16(a, qf[ks], sacc[mi]); } }
    const float nm = negmx[t]; float rs = 0.f;
#pragma unroll
    for (int mi = 0; mi < 8; ++mi)
#pragma unroll
        for (int r = 0; r < 4; ++r) { const int s = mi * 16 + 4 * g + r; const float p = (s <= t) ? sacc[mi][r] * __expf(nm + lib[s]) : 0.f; rs += p; sacc[mi][r] = p; }
    rs += __shfl_xor(rs, 16); rs += __shfl_xor(rs, 32);
    float qn = 0.f;
#pragma unroll
    for (int ks = 0; ks < 8; ++ks)
#pragma unroll
        for (int j = 0; j < 8; ++j) qn += bf2f((unsigned short)qf[ks][j]) * npv[ks * 32 + 8 * g + j];
    qn += __shfl_xor(qn, 16); qn += __shfl_xor(qn, 32);
    { const float den = inter[t] * qn + rs; const float dn = fmaxf(fabsf(den), emt[t]); if (g == 0) dens[t] = dn; }
    f32x4 o[16];
#pragma unroll
    for (int ni = 0; ni < 16; ++ni) o[ni] = (f32x4){0.f, 0.f, 0.f, 0.f};
    float itr[4], dr[4];
#pragma unroll
    for (int r = 0; r < 4; ++r) { itr[r] = inter[16 * wave + 4 * g + r]; dr[r] = 1.0f / dens[16 * wave + 4 * g + r]; }
    { const bf16* n1p = NUM1 + (size_t)(c * 128 + 16 * wave + 4 * g) * 1024 + h * 256 + tq;
#pragma unroll
      for (int ni = 0; ni < 16; ++ni)
#pragma unroll
          for (int r = 0; r < 4; ++r) o[ni][r] = itr[r] * bf2f(n1p[r * 1024 + ni * 16]); }

#pragma unroll
    for (int i = 0; i < 4; ++i) if (2 * i <= wave) {
        bf16x8 pa; { const unsigned a0 = pk2(sacc[2 * i][0], sacc[2 * i][1]), a1 = pk2(sacc[2 * i][2], sacc[2 * i][3]), a2 = pk2(sacc[2 * i + 1][0], sacc[2 * i + 1][1]), a3 = pk2(sacc[2 * i + 1][2], sacc[2 * i + 1][3]);
            const uint4 u = make_uint4(a0, a1, a2, a3); pa = __builtin_bit_cast(bf16x8, u); }
#pragma unroll
        for (int ni = 0; ni < 16; ++ni) { const bf16* vp = Vt + (ni * 16 + tq) * 136 + 32 * i + 4 * g; const uint2 lo = *(const uint2*)vp, hi = *(const uint2*)(vp + 16);
            const uint4 u = make_uint4(lo.x, lo.y, hi.x, hi.y); o[ni] = mma16(pa, __builtin_bit_cast(bf16x8, u), o[ni]); } }
    float ss[4] = {0.f, 0.f, 0.f, 0.f};
#pragma unroll
    for (int ni = 0; ni < 16; ++ni)
#pragma unroll
        for (int r = 0; r < 4; ++r) { o[ni][r] *= dr[r]; ss[r] += o[ni][r] * o[ni][r]; }
#pragma unroll
    for (int r = 0; r < 4; ++r) { ss[r] += __shfl_xor(ss[r], 1); ss[r] += __shfl_xor(ss[r], 2); ss[r] += __shfl_xor(ss[r], 4); ss[r] += __shfl_xor(ss[r], 8); ss[r] = rsqrtf(ss[r] * (1.0f / 256.0f) + EPS); }
#pragma unroll
    for (int ni = 0; ni < 16; ++ni) { const int v = ni * 16 + tq; const float gam = ((const float*)C.a.in[8])[h * 256 + v];
#pragma unroll
        for (int r = 0; r < 4; ++r) { bf16* p = MO + (size_t)(c * 128 + 16 * wave + 4 * g + r) * 1024 + h * 256 + v; const float mo = bf2f(*p);
#ifdef HM_GATE_ONLY
            *p = f2bf(gam * sigmoidf_(mo));
#else
            *p = f2bf(o[ni][r] * ss[r] * gam * sigmoidf_(mo));
#endif
        } }
    __syncthreads();
}

__device__ __forceinline__ void moba_select_item(Ctx& C, int item) {
    const int h = item >> 6, qb = item & 63, own = qb, tid = C.tid, lane = C.lane, wave = C.wave, g = lane >> 4, tq = lane & 15;
    int* CNT = (int*)(C.ws + WS_CNT); unsigned short* LIST = (unsigned short*)(C.ws + WS_LIST);
    if (own == 0) { if (tid < 64) CNT[(h * 64 + qb) * 64 + tid] = 0; return; }
    bf16* KMh = (bf16*)C.lds; bf16* KMl = KMh + 64 * 136; int* cnt = (int*)(C.lds + 2 * 64 * 136 * 2);
    const bf16* AQ = (const bf16*)(C.ws + WS_AQ); const float* KMEAN = (const float*)(C.ws + WS_KMEAN);
    for (int idx = tid; idx < 64 * 32; idx += 512) { const int n = idx >> 5, c4 = idx & 31; const float4 v = ((const float4*)(KMEAN + ((size_t)h * 64 + n) * 128))[c4];
        const unsigned short h0 = f2bf(v.x), h1 = f2bf(v.y), h2 = f2bf(v.z), h3 = f2bf(v.w);
        uint2 hi, lo; hi.x = (unsigned)h0 | ((unsigned)h1 << 16); hi.y = (unsigned)h2 | ((unsigned)h3 << 16);
        lo.x = pk2(v.x - bf2f(h0), v.y - bf2f(h1)); lo.y = pk2(v.z - bf2f(h2), v.w - bf2f(h3));
        *(uint2*)(KMh + n * 136 + c4 * 4) = hi; *(uint2*)(KMl + n * 136 + c4 * 4) = lo; }
    if (tid < 64) cnt[tid] = 0;
    __syncthreads();
    const float NINF = -__builtin_inff();
#define TOP3_INS(x, n) do { if ((x) > v1) { v3 = v2; i3 = i2; v2 = v1; i2 = i1; v1 = (x); i1 = (n); } else if ((x) > v2) { v3 = v2; i3 = i2; v2 = (x); i2 = (n); } else if ((x) > v3) { v3 = (x); i3 = (n); } } while (0)
#pragma unroll 1
    for (int rg = 0; rg < 2; ++rg) {
        const int ql = 32 * wave + 16 * rg + tq;
        bf16x8 qf[4];
        { const bf16* qrow = AQ + (size_t)(qb * 256 + ql) * 1024 + h * 128 + 8 * g;
#pragma unroll
          for (int ks = 0; ks < 4; ++ks) qf[ks] = *(const bf16x8*)(qrow + ks * 32); }
        float v1 = NINF, v2 = NINF, v3 = NINF; int i1 = -1, i2 = -1, i3 = -1;
#pragma unroll
        for (int mi = 0; mi < 4; ++mi) if (mi * 16 < own) {
            f32x4 acc = (f32x4){0.f, 0.f, 0.f, 0.f};
#pragma unroll
            for (int ks = 0; ks < 4; ++ks) { const bf16x8 ah = *(const bf16x8*)(KMh + (mi * 16 + tq) * 136 + ks * 32 + 8 * g), al = *(const bf16x8*)(KMl + (mi * 16 + tq) * 136 + ks * 32 + 8 * g);
                acc = mma16(ah, qf[ks], acc); acc = mma16(al, qf[ks], acc); }
#pragma unroll
            for (int r = 0; r < 4; ++r) { const int n = mi * 16 + 4 * g + r; if (n < own) { const float xv = acc[r]; TOP3_INS(xv, n); } }
        }
#pragma unroll
        for (int sh = 16; sh <= 32; sh <<= 1) {
            const float p1 = __shfl_xor(v1, sh), p2 = __shfl_xor(v2, sh), p3 = __shfl_xor(v3, sh); const int j1 = __shfl_xor(i1, sh), j2 = __shfl_xor(i2, sh), j3 = __shfl_xor(i3, sh);
            if (j1 >= 0) TOP3_INS(p1, j1); if (j2 >= 0) TOP3_INS(p2, j2); if (j3 >= 0) TOP3_INS(p3, j3);
        }
        if (g == 0) { const int sel[3] = {i1, i2, i3};
#pragma unroll
            for (int j = 0; j < 3; ++j) if (sel[j] >= 0) { const int pos = atomicAdd(&cnt[sel[j]], 1); LIST[((size_t)(h * 64 + sel[j]) * 64 + qb) * 256 + pos] = (unsigned short)((ql << 2) | j); } }
    }
#undef TOP3_INS
    __syncthreads();
    if (tid < 64) CNT[(h * 64 + qb) * 64 + tid] = (tid < own) ? cnt[tid] : 0;
    __syncthreads();
}
constexpr int MOBA_MAXT = 20;
__device__ __forceinline__ void moba_attn(Ctx& C) {
    const int tid = C.tid, lane = C.lane, wave = C.wave, g = lane >> 4, tq = lane & 15;
    bf16* Ks = (bf16*)C.lds; bf16* Vt = (bf16*)(C.lds + 69632);
    int* incl = (int*)(C.lds + 137216); int* wtot = incl + 512; int* tl_hn = wtot + 8; int* tl_arg = tl_hn + 24; int* tl_own = tl_arg + 24; int* segw = tl_own + 24; int* rowmap = segw + 8 * 66;
    const bf16* AQ = (const bf16*)(C.ws + WS_AQ); const bf16* AK = (const bf16*)(C.ws + WS_AK); const bf16* AV = (const bf16*)(C.ws + WS_AV);
    const int* CNT = (const int*)(C.ws + WS_CNT); const unsigned short* LIST = (const unsigned short*)(C.ws + WS_LIST);
    bf16* PART = (bf16*)C.out; float* LSE = (float*)(C.ws + WS_LSE);
    { int tot = 0; const int* cp = CNT + (tid >> 6) * 4096 + (tid & 63);
#pragma unroll
      for (int qb = 0; qb < 64; ++qb) tot += cp[qb * 64];
      const int nt = (tot + 127) >> 7; const int v = wave_incl_sum_i(nt, lane); if (lane == 63) wtot[wave] = v; __syncthreads();
      int off = 0; for (int w = 0; w < wave; ++w) off += wtot[w]; incl[tid] = v + off; __syncthreads(); }
    const int T = incl[511];
    const int f0 = (int)(((long)C.bid * T) / C.G), f1 = (int)(((long)(C.bid + 1) * T) / C.G);
    const int nown = (C.bid < 1024) ? (1024 - C.bid + C.G - 1) / C.G : 0;
    int ntile = nown + (f1 - f0); if (ntile > MOBA_MAXT) ntile = MOBA_MAXT;
    if (tid < ntile) {
        if (tid < nown) { const int it = C.bid + tid * C.G, hh = it >> 7, qt = it & 127; tl_hn[tid] = hh * 64 + (qt >> 1); tl_arg[tid] = qt; tl_own[tid] = 1; }
        else { const int f = f0 + (tid - nown); int lo = 0, hi = 511; while (lo < hi) { const int mid = (lo + hi) >> 1; if (incl[mid] > f) hi = mid; else lo = mid + 1; }
            tl_hn[tid] = lo; tl_arg[tid] = f - (lo ? incl[lo - 1] : 0); tl_own[tid] = 0; }
    }
    __syncthreads();
    for (int i = wave; i < ntile; i += 8) {
        const int hn = tl_hn[i], arg = tl_arg[i]; int* sw = segw + wave * 66;
        if (tl_own[i]) { rowmap[i * 128 + lane] = (arg * 128 + lane) * 4 + 3; rowmap[i * 128 + 64 + lane] = (arg * 128 + 64 + lane) * 4 + 3; }
        else { const int hh = hn >> 6, n = hn & 63; const int cv = CNT[(hh * 64 + lane) * 64 + n]; const int inc = wave_incl_sum_i(cv, lane); sw[lane] = inc - cv; if (lane == 63) sw[64] = inc;
            __builtin_amdgcn_s_waitcnt(0xc07f); asm volatile("" ::: "memory");
            const int tot = sw[64];
#pragma unroll
            for (int rr = 0; rr < 2; ++rr) { const int r = lane + 64 * rr, p = arg * 128 + r; int rm = -1;
                if (p < tot) { int lo = 0, hi = 64; while (hi - lo > 1) { const int mid = (lo + hi) >> 1; if (sw[mid] <= p) lo = mid; else hi = mid; }
                    const unsigned e = LIST[((size_t)hn * 64 + lo) * 256 + (p - sw[lo])]; rm = (lo * 256 + (int)(e >> 2)) * 4 + (int)(e & 3u); }
                rowmap[i * 128 + r] = rm; }
            __builtin_amdgcn_s_waitcnt(0xc07f); asm volatile("" ::: "memory"); }
    }
    __syncthreads();
    int cached = -1;
    bf16x8 qf[4];
    if (ntile > 0) { const int rm = rowmap[16 * wave + tq]; const int ql = rm < 0 ? 0 : (rm >> 2); const bf16* qrow = AQ + (size_t)ql * 1024 + (tl_hn[0] >> 6) * 128 + 8 * g;
#pragma unroll
        for (int ks = 0; ks < 4; ++ks) qf[ks] = *(const bf16x8*)(qrow + ks * 32); }
    for (int i = 0; i < ntile; ++i) {
        const int hn = tl_hn[i], h = hn >> 6, n = hn & 63; const bool is_own = tl_own[i] != 0;
        if (hn != cached) {
            __syncthreads();
#pragma unroll
            for (int ii = 0; ii < 8; ++ii) { const int idx = tid + ii * 512, row = idx >> 4, ch = idx & 15; *(uint4*)(Ks + row * 136 + ch * 8) = *(const uint4*)(AK + (size_t)(n * 256 + row) * 1024 + h * 128 + ch * 8); }
            { const int key = tid & 255, dgp = tid >> 8; const bf16* vrow = AV + (size_t)(n * 256 + key) * 1024 + h * 128;
#pragma unroll
              for (int ii = 0; ii < 8; ++ii) { const int dg = dgp * 8 + ii; const uint4 vv = *(const uint4*)(vrow + dg * 8); const unsigned wv[4] = {vv.x, vv.y, vv.z, vv.w};
#pragma unroll
                  for (int j = 0; j < 8; ++j) Vt[(dg * 8 + j) * 264 + key] = (unsigned short)((j & 1) ? (wv[j >> 1] >> 16) : (wv[j >> 1] & 0xffffu)); } }
            cached = hn;
            __syncthreads();
        }
        const int rmq = rowmap[i * 128 + 16 * wave + tq]; const int ql = rmq < 0 ? 0 : (rmq >> 2);
        f32x4 sacc[16];
#pragma unroll
        for (int mi = 0; mi < 16; ++mi) { sacc[mi] = (f32x4){0.f, 0.f, 0.f, 0.f};
#pragma unroll
            for (int ks = 0; ks < 4; ++ks) { const bf16x8 a = *(const bf16x8*)(Ks + (mi * 16 + tq) * 136 + ks * 32 + 8 * g); sacc[mi] = mma16(a, qf[ks], sacc[mi]); } }
        if (i + 1 < ntile) { const int rm = rowmap[(i + 1) * 128 + 16 * wave + tq]; const int qn_ = rm < 0 ? 0 : (rm >> 2); const bf16* qrow = AQ + (size_t)qn_ * 1024 + (tl_hn[i + 1] >> 6) * 128 + 8 * g;
#pragma unroll
            for (int ks = 0; ks < 4; ++ks) qf[ks] = *(const bf16x8*)(qrow + ks * 32); }
        const float scale = 0.08838834764831845f; const int qloc = is_own ? (ql - n * 256) : 100000; float mx = -__builtin_inff();
#pragma unroll
        for (int mi = 0; mi < 16; ++mi)
#pragma unroll
            for (int r = 0; r < 4; ++r) { const int key = mi * 16 + 4 * g + r; float sv = sacc[mi][r] * scale; if (key > qloc) sv = -__builtin_inff(); sacc[mi][r] = sv; mx = fmaxf(mx, sv); }
        mx = fmaxf(mx, __shfl_xor(mx, 16)); mx = fmaxf(mx, __shfl_xor(mx, 32));
        float l = 0.f;
#pragma unroll
        for (int mi = 0; mi < 16; ++mi)
#pragma unroll
            for (int r = 0; r < 4; ++r) { const float p = __expf(sacc[mi][r] - mx); l += p; sacc[mi][r] = p; }
        l += __shfl_xor(l, 16); l += __shfl_xor(l, 32);
        f32x4 o[8];
#pragma unroll
        for (int ni = 0; ni < 8; ++ni) o[ni] = (f32x4){0.f, 0.f, 0.f, 0.f};
#pragma unroll
        for (int k2 = 0; k2 < 8; ++k2) {
            bf16x8 pa; { const uint4 u = make_uint4(pk2(sacc[2 * k2][0], sacc[2 * k2][1]), pk2(sacc[2 * k2][2], sacc[2 * k2][3]), pk2(sacc[2 * k2 + 1][0], sacc[2 * k2 + 1][1]), pk2(sacc[2 * k2 + 1][2], sacc[2 * k2 + 1][3])); pa = __builtin_bit_cast(bf16x8, u); }
#pragma unroll
            for (int ni = 0; ni < 8; ++ni) { const bf16* vp = Vt + (ni * 16 + tq) * 264 + 32 * k2 + 4 * g; const uint2 lo = *(const uint2*)vp, hi = *(const uint2*)(vp + 16);
                const uint4 u = make_uint4(lo.x, lo.y, hi.x, hi.y); o[ni] = mma16(pa, __builtin_bit_cast(bf16x8, u), o[ni]); } }
#pragma unroll
        for (int r = 0; r < 4; ++r) { const float lr = __shfl(l, 4 * g + r); const float inv = 1.0f / lr; const int rm = rowmap[i * 128 + 16 * wave + 4 * g + r];
            if (rm >= 0) { bf16* dst = PART + ((size_t)((rm >> 2) * 8 + h) * 4 + (rm & 3)) * 128 + tq;
#pragma unroll
                for (int ni = 0; ni < 8; ++ni) dst[ni * 16] = f2bf(o[ni][r] * inv); } }
        if (g == 0 && rmq >= 0) __hip_atomic_store((unsigned*)LSE + (size_t)((rmq >> 2) * 8 + h) * 4 + (rmq & 3), __float_as_uint(mx + __logf(l)), __ATOMIC_RELAXED, __HIP_MEMORY_SCOPE_AGENT);
    }
    __syncthreads();
}
__device__ __forceinline__ void moba_combine(Ctx& C) {
    const bf16* PART = (const bf16*)C.out; const float* LSE = (const float*)(C.ws + WS_LSE); bf16* HA = (bf16*)(C.ws + WS_AQ);
    const int total = SEQ * 8 * 16;
    for (int idx = C.bid * 512 + C.tid; idx < total; idx += C.G * 512) {
        const int dg = idx & 15, h = (idx >> 4) & 7, q = idx >> 7; const int nsel = min(q >> 8, 3);
        const float4 ls = *(const float4*)(LSE + (size_t)(q * 8 + h) * 4); const float lv[4] = {ls.x, ls.y, ls.z, ls.w};
        float M = lv[3];
#pragma unroll
        for (int j = 0; j < 3; ++j) if (j < nsel) M = fmaxf(M, lv[j]);
        float acc[8], wsum = 0.f;
#pragma unroll
        for (int i = 0; i < 8; ++i) acc[i] = 0.f;
#pragma unroll
        for (int j = 0; j < 4; ++j) if (j == 3 || j < nsel) { const float w = __expf(lv[j] - M); wsum += w; float f[8]; unpack8(*(const uint4*)(PART + ((size_t)(q * 8 + h) * 4 + j) * 128 + dg * 8), f);
#pragma unroll
            for (int i = 0; i < 8; ++i) acc[i] += w * f[i]; }
        const float inv = 1.0f / wsum;
#pragma unroll
        for (int i = 0; i < 8; ++i) acc[i] *= inv;
#ifdef ZERO_HA
#pragma unroll
        for (int i = 0; i < 8; ++i) acc[i] = 0.f;
#endif
        *(uint4*)(HA + (size_t)q * 1024 + h * 128 + dg * 8) = pack8(acc);
    }
}

__device__ __forceinline__ void rows1(Ctx& C) {
    const bf16* MIX = (const bf16*)(C.ws + WS_GM); bf16* HN = (bf16*)(C.ws + WS_GA);
    const int gw = C.bid * 8 + C.wave, NGW = C.G * 8, lane = C.lane;
    for (int row = gw; row < SEQ; row += NGW) {
        float m[4][8]; float ss = 0.f;
#pragma unroll
        for (int j = 0; j < 4; ++j) { unpack8(*(const uint4*)(MIX + (size_t)row * DM + 512 * j + 8 * lane), m[j]);
#pragma unroll
            for (int i = 0; i < 8; ++i) ss += m[j][i] * m[j][i]; }
        const float rstd = rsqrtf(wave_sum(ss) * (1.f / DM) + EPS); float ss2 = 0.f;
#ifdef ZERO_MIX
#pragma unroll
        for (int j = 0; j < 4; ++j)
#pragma unroll
            for (int i = 0; i < 8; ++i) m[j][i] = 0.f;
#endif
#pragma unroll
        for (int j = 0; j < 4; ++j) { const int k = 512 * j + 8 * lane; const float4* xp = (const float4*)(((const float*)C.a.in[0]) + (size_t)row * DM + k); const float4* wp = (const float4*)(((const float*)C.a.in[12]) + k);
            const float4 xa = xp[0], xb = xp[1], wa = wp[0], wb = wp[1];
            m[j][0] = xa.x + m[j][0] * rstd * wa.x; m[j][1] = xa.y + m[j][1] * rstd * wa.y; m[j][2] = xa.z + m[j][2] * rstd * wa.z; m[j][3] = xa.w + m[j][3] * rstd * wa.w;
            m[j][4] = xb.x + m[j][4] * rstd * wb.x; m[j][5] = xb.y + m[j][5] * rstd * wb.y; m[j][6] = xb.z + m[j][6] * rstd * wb.z; m[j][7] = xb.w + m[j][7] * rstd * wb.w;
            *(uint4*)((bf16*)(C.out + (size_t)row * DM + DM / 2) + k) = pack8(m[j]);
#pragma unroll
            for (int i = 0; i < 8; ++i) ss2 += m[j][i] * m[j][i]; }
        const float rstd2 = rsqrtf(wave_sum(ss2) * (1.f / DM) + EPS);
#pragma unroll
        for (int j = 0; j < 4; ++j) { const int k = 512 * j + 8 * lane; const float4* wp = (const float4*)(((const float*)C.a.in[13]) + k); const float4 wa = wp[0], wb = wp[1];
            float o[8] = {m[j][0] * rstd2 * wa.x, m[j][1] * rstd2 * wa.y, m[j][2] * rstd2 * wa.z, m[j][3] * rstd2 * wa.w, m[j][4] * rstd2 * wb.x, m[j][5] * rstd2 * wb.y, m[j][6] * rstd2 * wb.z, m[j][7] * rstd2 * wb.w};
            *(uint4*)(HN + (size_t)row * DM + k) = pack8(o); }
    }
}
__device__ __forceinline__ void rows2(Ctx& C) {
    const bf16* Y = (const bf16*)(C.ws + WS_GA);
    const int gw = C.bid * 8 + C.wave, NGW = C.G * 8, lane = C.lane;
    for (int row = gw; row < SEQ; row += NGW) {
        float m[4][8], x1[4][8]; float ss = 0.f;
#pragma unroll
        for (int j = 0; j < 4; ++j) { unpack8(*(const uint4*)(Y + (size_t)row * DM + 512 * j + 8 * lane), m[j]);
            unpack8(*(const uint4*)((const bf16*)(C.out + (size_t)row * DM + DM / 2) + 512 * j + 8 * lane), x1[j]);
#pragma unroll
            for (int i = 0; i < 8; ++i) ss += m[j][i] * m[j][i]; }
        const float rstd = rsqrtf(wave_sum(ss) * (1.f / DM) + EPS);
        asm volatile("s_waitcnt vmcnt(0)" ::: "memory");
#pragma unroll
        for (int j = 0; j < 4; ++j) { const int k = 512 * j + 8 * lane; float4* op = (float4*)(C.out + (size_t)row * DM + k); const float4* wp = (const float4*)(((const float*)C.a.in[16]) + k);
            const float4 wa = wp[0], wb = wp[1];
            op[0] = make_float4(x1[j][0] + m[j][0] * rstd * wa.x, x1[j][1] + m[j][1] * rstd * wa.y, x1[j][2] + m[j][2] * rstd * wa.z, x1[j][3] + m[j][3] * rstd * wa.w);
            op[1] = make_float4(x1[j][4] + m[j][4] * rstd * wb.x, x1[j][5] + m[j][5] * rstd * wb.y, x1[j][6] + m[j][6] * rstd * wb.z, x1[j][7] + m[j][7] * rstd * wb.w); }
    }
}


#define XB_TMO      128
#define XB_XCNT(j)  (256  + 64 * (j))
#define XB_XSUB(j)  (1280 + 64 * (j))
#define XB_XGEN(j)  (2304 + 64 * (j))
#define XB_TOP      3328
#define XB_TOPGEN   3392
#define XCD_BAR_WORDS 3456
#define XB_SPIN_CAP (1u << 18)

__device__ __forceinline__ unsigned xb_ld(unsigned* p)              { return __hip_atomic_load(p, __ATOMIC_RELAXED, __HIP_MEMORY_SCOPE_AGENT); }
__device__ __forceinline__ unsigned xb_add(unsigned* p, unsigned v) { return __hip_atomic_fetch_add(p, v, __ATOMIC_RELAXED, __HIP_MEMORY_SCOPE_AGENT); }
__device__ __forceinline__ unsigned xb_xcc_id() { return (unsigned)__builtin_amdgcn_s_getreg((3 << 11) | 20) & 0xFu; }
#define XB_SPIN(cond, bar) do { unsigned _sp = 0; while (cond) { __builtin_amdgcn_s_sleep(1); \
    if ((++_sp & 255u) == 0u) { if (xb_ld(&(bar)[XB_TMO])) break; if (_sp > XB_SPIN_CAP) { atomicAdd(&(bar)[XB_TMO], 1u); break; } } } } while (0)

struct XcdBarrier {
    unsigned* bar; unsigned x;
    volatile unsigned* st;
};

__device__ __forceinline__ XcdBarrier xcd_barrier_post(unsigned* bar, volatile unsigned* st) {
    XcdBarrier b; b.bar = bar; b.x = xb_xcc_id(); b.st = st;
    if (threadIdx.x == 0) (void)xb_add(&bar[XB_XCNT(b.x)], 1u);
    return b;
}
__device__ __forceinline__ void xcd_barrier_complete(unsigned* bar, unsigned x, unsigned& nloc, unsigned& nx) {
    const unsigned G = gridDim.x * gridDim.y * gridDim.z;
    unsigned sum, cnt, mine, sp = 0u;
    for (;;) {
        sum = 0u; cnt = 0u; mine = 0u;
#pragma unroll
        for (unsigned j = 0; j < 16; ++j) { const unsigned c = xb_ld(&bar[XB_XCNT(j)]); sum += c; cnt += (c > 0u) ? 1u : 0u; mine = (j == x) ? c : mine; }
        if (sum == G) break;
        __builtin_amdgcn_s_sleep(1);
        if ((++sp & 255u) == 0u) { if (xb_ld(&bar[XB_TMO])) break; if (sp > XB_SPIN_CAP) { atomicAdd(&bar[XB_TMO], 1u); break; } }
    }
    nloc = mine > 0u ? mine : 1u; nx = cnt > 0u ? cnt : 1u;
}

__device__ __forceinline__ void xcd_barrier(const XcdBarrier& b) {
    asm volatile("s_waitcnt vmcnt(0)" ::: "memory");
    __syncthreads();
    if (threadIdx.x == 0) {
        unsigned* bar = b.bar;
        __builtin_amdgcn_s_waitcnt(0);
        unsigned nloc = b.st[0], nx = b.st[1];
        if (nloc == 0u) { xcd_barrier_complete(bar, b.x, nloc, nx); b.st[0] = nloc; b.st[1] = nx; }
        const unsigned old = xb_add(&bar[XB_XSUB(b.x)], 1u);
        const unsigned gen = old / nloc;
        if (old + 1u == (gen + 1u) * nloc) {
            __builtin_amdgcn_fence(__ATOMIC_RELEASE, "agent");
            asm volatile("s_waitcnt vmcnt(0)" ::: "memory");
            const unsigned og = xb_add(&bar[XB_TOP], 1u);
            const unsigned tg = og / nx;
            if (og + 1u == (tg + 1u) * nx) xb_add(&bar[XB_TOPGEN], 1u);
            else XB_SPIN(xb_ld(&bar[XB_TOPGEN]) == tg, bar);
            __builtin_amdgcn_fence(__ATOMIC_ACQUIRE, "agent");
            xb_add(&bar[XB_XGEN(b.x)], 1u);
            asm volatile("s_waitcnt vmcnt(0)" ::: "memory");
        } else {
            XB_SPIN(xb_ld(&bar[XB_XGEN(b.x)]) == gen, bar);
            __builtin_amdgcn_fence(__ATOMIC_ACQUIRE, "agent");
            asm volatile("s_waitcnt vmcnt(0)" ::: "memory");
        }
    }
    __syncthreads();
}

constexpr int NPHASE = 14;
template <class Epi> __device__ __forceinline__ void run_gemm(Ctx& C, const bf16* A, const bf16* Bt, int N, int K, const Epi& E) {
    pg8::Gemm g{A, Bt, SEQ, N, K}; pg8::StaticOrder S; S.init(SEQ, N, C.G, C.bid);
    pg8::gemm_phase<Epi, pg8::StaticOrder, false>((PG8_LAS unsigned char*)C.lds, g, S, E, nullptr);
}
__global__ void __launch_bounds__(512, 2) fwd_kernel(Args a) {
    extern __shared__ __attribute__((aligned(16))) unsigned char lds[];
    cg::grid_group grid = cg::this_grid();
    Ctx C{lds, (int)threadIdx.x, (int)(threadIdx.x & 63), __builtin_amdgcn_readfirstlane((int)(threadIdx.x >> 6)), (int)gridDim.x, (int)blockIdx.x, a, a.out, a.ws};
    volatile unsigned* xst = (volatile unsigned*)(lds + LDS_BYTES - 64);
    if (threadIdx.x < 2) xst[threadIdx.x] = 0u;
    __syncthreads();
    XcdBarrier xbar = xcd_barrier_post((unsigned*)(a.ws + WS_BAR), xst);
    const int lo = a.ph_lo, hi = a.ph_hi;
#ifndef PHMASK
#define PHMASK 0xffff
#endif
#define IN(k) (((PHMASK >> (k)) & 1) && lo <= (k) && (k) < hi)
#define SEAM(k) do { if (IN(k) && IN((k) + 1)) { xcd_barrier(xbar); } } while (0)
    unsigned char* ws = a.ws;
    if (hi > NPHASE) grid.sync();
    if (IN(0)) phase0(C);
    SEAM(0);
    if (IN(1)) { pg8::EpiSplit E{(bf16*)(ws + WS_MQK), (bf16*)(ws + WS_MV), (bf16*)(ws + WS_GM), (bf16*)(ws + WS_GA)}; run_gemm(C, (const bf16*)C.out, (const bf16*)(ws + WS_WIN), NPROJ, DM, E); }
    SEAM(1);
    if (IN(2)) phase2(C);
    SEAM(2);
    if (IN(3)) { for (int it = C.bid; it < 512; it += C.G) mlstm_local_item(C, it);
                 for (int it = C.bid; it < 512; it += C.G) moba_select_item(C, it); }
    SEAM(3);
    if (IN(4)) { mlstm_scan(C); convert_ffn_weights(C, C.G >= 192 ? 129 : 0); }
    SEAM(4);
    if (IN(5)) { for (int it = C.bid; it < 512; it += C.G) mlstm_num1_item(C, it);
                 xcd_barrier(xbar);
                 for (int it = C.bid; it < 512; it += C.G) mlstm_out_item(C, it); }
    SEAM(5);
    if (IN(6)) moba_attn(C);
    SEAM(6);
    if (IN(7)) moba_combine(C);
    SEAM(7);
    if (IN(8)) { pg8::EpiB<1> E1{(bf16*)(ws + WS_MQK), DM, (const bf16*)(ws + WS_GM)}; run_gemm(C, (const bf16*)(ws + WS_MO), (const bf16*)(ws + WS_WBM), DM, 1024, E1);
                 pg8::EpiB<2> E2{(bf16*)(ws + WS_MQK), DM, (const bf16*)(ws + WS_GA)}; run_gemm(C, (const bf16*)(ws + WS_AQ), (const bf16*)(ws + WS_WBA), DM, 1024, E2); }
    SEAM(8);
    if (IN(9)) { pg8::EpiB<0> E{(bf16*)(ws + WS_GM), DM, nullptr}; run_gemm(C, (const bf16*)(ws + WS_MQK), (const bf16*)(ws + WS_WOUT), DM, DM, E); }
    SEAM(9);
    if (IN(10)) rows1(C);
    SEAM(10);
    if (IN(11)) { pg8::EpiB<3> E{(bf16*)(ws + WS_U), DFF, nullptr}; run_gemm(C, (const bf16*)(ws + WS_GA), (const bf16*)(ws + WS_WUP), DFF, DM, E); }
    SEAM(11);
    if (IN(12)) { pg8::EpiB<0> E{(bf16*)(ws + WS_GA), DM, nullptr}; run_gemm(C, (const bf16*)(ws + WS_U), (const bf16*)(ws + WS_WDOWN), DM, DFF, E); }
    SEAM(12);
    if (IN(13)) rows2(C);
#undef IN
#undef SEAM
}

#ifndef MK_SPLIT
#define MK_SPLIT 0
#endif
extern "C" void kernel_launch(void* const* d_in, const int* in_sizes, int n_in, void* d_out, int out_size, void* d_ws, size_t ws_size, hipStream_t stream) {
    static int grid = 0;
    if (grid == 0) {
        if (n_in != 17 || out_size != SEQ * DM || ws_size < WS_NEED) { fprintf(stderr, "kernel_launch: unexpected shapes (n_in %d out %d ws %zu)\n", n_in, out_size, ws_size); grid = -1; return; }
        int dev = 0, cus = 0, per_cu = 0;
        hipGetDevice(&dev); hipDeviceGetAttribute(&cus, hipDeviceAttributeMultiprocessorCount, dev);
        if (hipFuncSetAttribute((const void*)fwd_kernel, hipFuncAttributeMaxDynamicSharedMemorySize, LDS_BYTES) != hipSuccess) { fprintf(stderr, "kernel_launch: hipFuncSetAttribute failed\n"); grid = -1; return; }
        if (hipOccupancyMaxActiveBlocksPerMultiprocessor(&per_cu, (const void*)fwd_kernel, 512, LDS_BYTES) != hipSuccess || per_cu < 1) { fprintf(stderr, "kernel_launch: occupancy query says %d\n", per_cu); per_cu = 1; }
        (void)hipGetLastError();
        grid = cus;
    }
    if (grid < 0) return;
    if (hipMemsetAsync((unsigned char*)d_ws + WS_BAR, 0, 16384, stream) != hipSuccess) { fprintf(stderr, "kernel_launch: memset failed\n"); return; }
    Args a{};
    for (int i = 0; i < 17; ++i) a.in[i] = d_in[i];
    a.out = (float*)d_out; a.ws = (unsigned char*)d_ws;
#if MK_SPLIT
    for (int p = 0; p < NPHASE; ++p) { a.ph_lo = p; a.ph_hi = p + 1; hipLaunchKernelGGL(fwd_kernel, dim3(grid), dim3(512), LDS_BYTES, stream, a); }
#else
    a.ph_lo = 0; a.ph_hi = NPHASE;
    void* args[] = {&a};
    hipError_t e = hipLaunchCooperativeKernel((const void*)fwd_kernel, dim3(grid), dim3(512), args, LDS_BYTES, stream);
    if (e != hipSuccess) fprintf(stderr, "kernel_launch: cooperative launch failed: %s (grid %d)\n", hipGetErrorString(e), grid);
#endif
}
```
